# Optimizing an MI355X kernel written in HIP

```python
import math
import jax, jax.numpy as jnp
from jax import lax
import numpy as np

D_MODEL = 2048
BATCH = 1
SEQ = 16384
DEPTH = 2

FOX_HEADS = 8
FOX_HEAD_DIM = 128
FOX_WIDTH = FOX_HEADS * FOX_HEAD_DIM
Q_BLOCK = 128
SSM_WIDTH = D_MODEL // 2
SSM_GROUP = 16
SSM_GROUPS = SSM_WIDTH // SSM_GROUP
SSM_STATE = 64
SWA_HEAD_DIM = 64
SWA_Q_HEADS = D_MODEL // SWA_HEAD_DIM
SWA_Q_PER_KV = 8
SWA_KV_HEADS = SWA_Q_HEADS // SWA_Q_PER_KV
WINDOW = 128
SWA_BLOCK = WINDOW
ROT_DIM = SWA_HEAD_DIM // 4
ROPE_THETA = 500000.0
D_FF = ((8 * D_MODEL + 3 * 256 - 1) // (3 * 256)) * 256
DEEPNORM_ALPHA = (2 * DEPTH) ** 0.25
DEEPNORM_BETA = (8 * DEPTH) ** -0.25
LN_EPS = 1e-5
N_EVEN = (DEPTH + 1) // 2
N_ODD = DEPTH // 2
EVEN_IN = 3 * FOX_WIDTH + FOX_HEADS + SSM_WIDTH
ODD_IN = (SWA_Q_HEADS + 2 * SWA_KV_HEADS) * SWA_HEAD_DIM

kernel_name = 'hybrid_fox_s5_swa_deepnorm_adaln'


def layer_norm(x, g, b):
    xf = x.astype(jnp.float32)
    mu = jnp.mean(xf, axis=-1, keepdims=True)
    var = jnp.mean(jnp.square(xf - mu), axis=-1, keepdims=True)
    y = (xf - mu) * lax.rsqrt(var + LN_EPS) * g.astype(jnp.float32) + b.astype(jnp.float32)
    return y.astype(x.dtype)


def partial_rotary(x, positions):
    half = ROT_DIM // 2
    inv_freq = jnp.power(jnp.float32(ROPE_THETA), -jnp.arange(half, dtype=jnp.float32) * (2.0 / ROT_DIM))
    ang = positions.astype(jnp.float32)[:, :, None] * inv_freq
    cos = jnp.cos(ang)[:, :, None, :]
    sin = jnp.sin(ang)[:, :, None, :]
    xf = x.astype(jnp.float32)
    x1 = xf[..., :half]
    x2 = xf[..., half:ROT_DIM]
    out = jnp.concatenate([x1 * cos - x2 * sin, x2 * cos + x1 * sin, xf[..., ROT_DIM:]], axis=-1)
    return out.astype(x.dtype)


def forgetting_attention(q, k, v, log_f):
    B, L, H, d = q.shape
    nb = L // Q_BLOCK
    scale = 1.0 / math.sqrt(d)
    Fk = lax.cumsum(log_f, axis=1).transpose(0, 2, 1)
    Fq_blocks = Fk.reshape(B, H, nb, Q_BLOCK).transpose(2, 0, 1, 3)
    q_blocks = q.reshape(B, nb, Q_BLOCK, H, d).transpose(1, 0, 2, 3, 4)
    kpos = jnp.arange(L)

    def one_block(args):
        qb, Fq, n = args
        s = jnp.einsum('bqhd,bshd->bhqs', qb, k).astype(jnp.float32) * scale
        s = s + Fq[:, :, :, None] - Fk[:, :, None, :]
        qpos = n * Q_BLOCK + jnp.arange(Q_BLOCK)
        causal = kpos[None, :] <= qpos[:, None]
        s = jnp.where(causal[None, None], s, -jnp.inf)
        p = jax.nn.softmax(s, axis=-1)
        return jnp.einsum('bhqs,bshd->bqhd', p.astype(v.dtype), v)

    out = lax.map(one_block, (q_blocks, Fq_blocks, jnp.arange(nb)))
    return out.transpose(1, 0, 2, 3, 4).reshape(B, L, H * d)


def _complex_affine_combine(e1, e2):
    a1r, a1i, b1r, b1i = e1
    a2r, a2i, b2r, b2i = e2
    ar = a2r * a1r - a2i * a1i
    ai = a2r * a1i + a2i * a1r
    br = a2r * b1r - a2i * b1i + b2r
    bi = a2r * b1i + a2i * b1r + b2i
    return (ar, ai, br, bi)


def s5_ssm(u, lam_re, lam_im, log_dt, b_re, b_im, c_re, c_im, d_skip):
    B_, L, _ = u.shape
    f32 = jnp.float32
    uf = u.astype(f32).reshape(B_, L, SSM_GROUPS, SSM_GROUP)
    lam_re = lam_re.astype(f32)
    lam_im = lam_im.astype(f32)
    dt = jnp.exp(log_dt.astype(f32))[:, None]
    mag = jnp.exp(lam_re * dt)
    lb_re = mag * jnp.cos(lam_im * dt)
    lb_im = mag * jnp.sin(lam_im * dt)
    den = lam_re * lam_re + lam_im * lam_im
    nr = lb_re - 1.0
    q_re = (nr * lam_re + lb_im * lam_im) / den
    q_im = (lb_im * lam_re - nr * lam_im) / den
    br = b_re.astype(f32)
    bi = b_im.astype(f32)
    bb_re = q_re[..., None] * br - q_im[..., None] * bi
    bb_im = q_re[..., None] * bi + q_im[..., None] * br
    bu_re = jnp.einsum('blgh,gph->blgp', uf, bb_re)
    bu_im = jnp.einsum('blgh,gph->blgp', uf, bb_im)
    a_re = jnp.broadcast_to(lb_re, bu_re.shape)
    a_im = jnp.broadcast_to(lb_im, bu_im.shape)
    _, _, x_re, x_im = lax.associative_scan(_complex_affine_combine, (a_re, a_im, bu_re, bu_im), axis=1)
    y = (jnp.einsum('ghp,blgp->blgh', c_re.astype(f32), x_re)
         - jnp.einsum('ghp,blgp->blgh', c_im.astype(f32), x_im)
         + d_skip.astype(f32) * uf)
    return y.reshape(B_, L, SSM_WIDTH)


def even_mixer(h, w_in, b_forget, lam_re, lam_im, log_dt, b_re, b_im, c_re, c_im, d_skip, w_glu, b_glu, w_out):
    B, L, _ = h.shape
    proj = h @ w_in
    W = FOX_WIDTH
    q = proj[..., 0:W].reshape(B, L, FOX_HEADS, FOX_HEAD_DIM)
    k = proj[..., W:2 * W].reshape(B, L, FOX_HEADS, FOX_HEAD_DIM)
    v = proj[..., 2 * W:3 * W].reshape(B, L, FOX_HEADS, FOX_HEAD_DIM)
    f_logit = proj[..., 3 * W:3 * W + FOX_HEADS].astype(jnp.float32) + b_forget.astype(jnp.float32)
    u = proj[..., 3 * W + FOX_HEADS:]
    a_out = forgetting_attention(q, k, v, jax.nn.log_sigmoid(f_logit))
    s = jax.nn.gelu(s5_ssm(u, lam_re, lam_im, log_dt, b_re, b_im, c_re, c_im, d_skip))
    s = s * jax.nn.sigmoid(s @ w_glu.astype(jnp.float32) + b_glu.astype(jnp.float32))
    return jnp.concatenate([a_out, s.astype(h.dtype)], axis=-1) @ w_out


def sliding_window_sink_attention(q, k, v, sinks):
    B, L, Hq, dh = q.shape
    nb = L // SWA_BLOCK
    scale = 1.0 / math.sqrt(dh)
    qb = q.reshape(B, nb, SWA_BLOCK, SWA_KV_HEADS, SWA_Q_PER_KV, dh)
    kb = k.reshape(B, nb, SWA_BLOCK, SWA_KV_HEADS, dh)
    vb = v.reshape(B, nb, SWA_BLOCK, SWA_KV_HEADS, dh)
    zk = jnp.zeros_like(kb[:, :1])
    kk = jnp.concatenate([jnp.concatenate([zk, kb[:, :-1]], axis=1), kb], axis=2)
    vv = jnp.concatenate([jnp.concatenate([zk, vb[:, :-1]], axis=1), vb], axis=2)
    s = jnp.einsum('bnqkgd,bnskd->bnkgqs', qb, kk).astype(jnp.float32) * scale
    qi = jnp.arange(SWA_BLOCK)[:, None]
    kj = jnp.arange(2 * SWA_BLOCK)[None, :]
    rel = qi + SWA_BLOCK - kj
    band = (rel >= 0) & (rel < WINDOW)
    valid = (jnp.arange(nb)[:, None, None] * SWA_BLOCK + kj[None] - SWA_BLOCK) >= 0
    mask = band[None] & valid
    s = jnp.where(mask[None, :, None, None], s, -jnp.inf)
    sink = sinks.astype(jnp.float32).reshape(SWA_KV_HEADS, SWA_Q_PER_KV)[None, None, :, :, None, None]
    m = jnp.maximum(jnp.max(s, axis=-1, keepdims=True), sink)
    p = jnp.exp(s - m)
    p = p / (jnp.sum(p, axis=-1, keepdims=True) + jnp.exp(sink - m))
    out = jnp.einsum('bnkgqs,bnskd->bnqkgd', p.astype(v.dtype), vv)
    return out.reshape(B, L, Hq * dh)


def odd_mixer(h, positions, w_in, sinks, w_out):
    B, L, _ = h.shape
    proj = h @ w_in
    qw = SWA_Q_HEADS * SWA_HEAD_DIM
    kw = SWA_KV_HEADS * SWA_HEAD_DIM
    q = proj[..., :qw].reshape(B, L, SWA_Q_HEADS, SWA_HEAD_DIM)
    k = proj[..., qw:qw + kw].reshape(B, L, SWA_KV_HEADS, SWA_HEAD_DIM)
    v = proj[..., qw + kw:].reshape(B, L, SWA_KV_HEADS, SWA_HEAD_DIM)
    q = partial_rotary(q, positions)
    k = partial_rotary(k, positions)
    return sliding_window_sink_attention(q, k, v, sinks) @ w_out


def swiglu(h, w_gate, w_up, w_down):
    return (jax.nn.silu(h @ w_gate) * (h @ w_up)) @ w_down


def setup_inputs(seed: int = 0) -> dict:
    key = jax.random.key(seed)
    ks = jax.random.split(key, 32)
    f32 = jnp.float32

    def nrm(k, shape, scale):
        return jax.random.normal(k, shape, f32) * scale

    G, P, H = SSM_GROUPS, SSM_STATE, SSM_GROUP
    n_idx = jnp.arange(P, dtype=f32)
    mix_w = FOX_WIDTH + SSM_WIDTH
    return {
        'x': nrm(ks[0], (BATCH, SEQ, D_MODEL), 1.0),
        'c': nrm(ks[1], (BATCH, D_MODEL), 1.0),
        'positions': jnp.broadcast_to(jnp.arange(SEQ, dtype=jnp.int32)[None, :], (BATCH, SEQ)),
        'w_in_ab': nrm(ks[2], (N_EVEN, D_MODEL, EVEN_IN), D_MODEL ** -0.5),
        'b_forget': 3.0 + nrm(ks[3], (N_EVEN, FOX_HEADS), 0.1),
        'ssm_lambda_re': -0.5 + nrm(ks[4], (N_EVEN, G, P), 0.01),
        'ssm_lambda_im': math.pi * n_idx + nrm(ks[5], (N_EVEN, G, P), 0.01),
        'ssm_log_dt': jax.random.uniform(ks[6], (N_EVEN, G), f32, math.log(1e-3), math.log(1e-1)),
        'ssm_b_re': nrm(ks[7], (N_EVEN, G, P, H), (2 * H) ** -0.5),
        'ssm_b_im': nrm(ks[8], (N_EVEN, G, P, H), (2 * H) ** -0.5),
        'ssm_c_re': nrm(ks[9], (N_EVEN, G, H, P), P ** -0.5),
        'ssm_c_im': nrm(ks[10], (N_EVEN, G, H, P), P ** -0.5),
        'ssm_d': nrm(ks[11], (N_EVEN, G, H), 1.0),
        'w_glu': nrm(ks[12], (N_EVEN, SSM_WIDTH, SSM_WIDTH), SSM_WIDTH ** -0.5),
        'b_glu': nrm(ks[13], (N_EVEN, SSM_WIDTH), 0.01),
        'w_out_ab': nrm(ks[14], (N_EVEN, mix_w, D_MODEL), DEEPNORM_BETA * mix_w ** -0.5),
        'w_in_c': nrm(ks[15], (N_ODD, D_MODEL, ODD_IN), D_MODEL ** -0.5),
        'attn_sinks': nrm(ks[16], (N_ODD, SWA_Q_HEADS), 0.5),
        'w_out_c': nrm(ks[17], (N_ODD, SWA_Q_HEADS * SWA_HEAD_DIM, D_MODEL), DEEPNORM_BETA * (SWA_Q_HEADS * SWA_HEAD_DIM) ** -0.5),
        'w_ada': nrm(ks[18], (DEPTH, D_MODEL, 6 * D_MODEL), 0.5 * D_MODEL ** -0.5),
        'b_ada': nrm(ks[19], (DEPTH, 6 * D_MODEL), 0.01),
        'ln_mix_g': 1.0 + nrm(ks[20], (DEPTH, D_MODEL), 0.02),
        'ln_mix_b': nrm(ks[21], (DEPTH, D_MODEL), 0.01),
        'ln_ffn_g': 1.0 + nrm(ks[22], (DEPTH, D_MODEL), 0.02),
        'ln_ffn_b': nrm(ks[23], (DEPTH, D_MODEL), 0.01),
        'w_ffn_gate': nrm(ks[24], (DEPTH, D_MODEL, D_FF), D_MODEL ** -0.5),
        'w_ffn_up': nrm(ks[25], (DEPTH, D_MODEL, D_FF), D_MODEL ** -0.5),
        'w_ffn_down': nrm(ks[26], (DEPTH, D_FF, D_MODEL), DEEPNORM_BETA * D_FF ** -0.5),
    }


def reference(x, c, positions, w_in_ab, b_forget, ssm_lambda_re, ssm_lambda_im, ssm_log_dt,
              ssm_b_re, ssm_b_im, ssm_c_re, ssm_c_im, ssm_d, w_glu, b_glu, w_out_ab,
              w_in_c, attn_sinks, w_out_c, w_ada, b_ada, ln_mix_g, ln_mix_b, ln_ffn_g, ln_ffn_b,
              w_ffn_gate, w_ffn_up, w_ffn_down):
    for layer in range(DEPTH):
        mod = jax.nn.silu(c) @ w_ada[layer] + b_ada[layer]
        sh1, sc1, g1, sh2, sc2, g2 = jnp.split(mod, 6, axis=-1)
        h = x * (1.0 + sc1[:, None, :]) + sh1[:, None, :]
        i = layer // 2
        if layer % 2 == 0:
            y = even_mixer(h, w_in_ab[i], b_forget[i], ssm_lambda_re[i], ssm_lambda_im[i], ssm_log_dt[i],
                           ssm_b_re[i], ssm_b_im[i], ssm_c_re[i], ssm_c_im[i], ssm_d[i],
                           w_glu[i], b_glu[i], w_out_ab[i])
        else:
            y = odd_mixer(h, positions, w_in_c[i], attn_sinks[i], w_out_c[i])
        x = layer_norm(DEEPNORM_ALPHA * x + g1[:, None, :] * y, ln_mix_g[layer], ln_mix_b[layer])
        h = x * (1.0 + sc2[:, None, :]) + sh2[:, None, :]
        y = swiglu(h, w_ffn_gate[layer], w_ffn_up[layer], w_ffn_down[layer])
        x = layer_norm(DEEPNORM_ALPHA * x + g2[:, None, :] * y, ln_ffn_g[layer], ln_ffn_b[layer])
    return x
```

```cpp
#include <hip/hip_runtime.h>
#include <hip/hip_cooperative_groups.h>
#include <cstdio>
#include <cstdint>
#include <cstring>
namespace cg = cooperative_groups;
namespace pg8 {
#define PG8_LAS __attribute__((address_space(3)))
typedef unsigned short bf16_t;
typedef short bf16x8 __attribute__((ext_vector_type(8)));
typedef float f32x4 __attribute__((ext_vector_type(4)));
typedef unsigned u32x4 __attribute__((ext_vector_type(4)));
constexpr int BM = 256, BK = 64, HALF = 128, HTB = HALF * BK * 2  , STAGE_BYTES = 8 * HTB, NXCD = 8, WGM = 4;

__host__ __device__ __forceinline__ int lds_byte(int r, int c) { const int st = (r >> 4) * 2 + (c >> 5), rr = r & 15, cc = c & 31, ob = rr * 64 + cc * 2; return st * 1024 + (ob ^ (((ob >> 9) & 1) << 5)); }
__host__ __device__ __forceinline__ void stage_rc(int b, int& R, int& C) { const int st = b / 1024, sb = b % 1024, swz = sb ^ (((sb >> 9) & 1) << 5); R = (st >> 1) * 16 + swz / 64; C = (st & 1) * 32 + (swz % 64) / 2; }
__host__ __device__ __forceinline__ int perm32(int rho) { const int n = rho >> 4, i = rho & 15; return 8 * (i >> 2) + 4 * n + (i & 3); }

struct Unit { int pm, pn; };
struct Gemm { const bf16_t* A; const bf16_t* Bt; int M, N, K; };

struct StaticOrder {
    int nM, nN, nwg, G, c;
    __host__ __device__ void init(int M, int N, int G_, int c_) { nM = M / BM; nN = N / BM; nwg = nM * nN; G = G_; c = c_; }
    __host__ __device__ bool next(int i, Unit& u) const {
        const long L = (long)i * G + c; if (L >= nwg) return false;
        int wgid = (int)L; { const int q = nwg / NXCD, r = nwg % NXCD, xcd = wgid % NXCD, off = wgid / NXCD; wgid = (xcd < r ? xcd * (q + 1) : r * (q + 1) + (xcd - r) * q) + off; }
        const int nig = WGM * nN, gid = wgid / nig, fm = gid * WGM, gsz = (nM - fm) < WGM ? (nM - fm) : WGM;
        u.pm = fm + ((wgid % nig) % gsz); u.pn = (wgid % nig) / gsz; return true;
    }
    __device__ __forceinline__ void a_ready(const Unit&) const {}
    __device__ __forceinline__ void done(const Unit&) const {}
};

__device__ __forceinline__ unsigned cvt_pk_bf16(float lo, float hi) { unsigned r; asm volatile("v_cvt_pk_bf16_f32 %0, %1, %2" : "=v"(r) : "v"(lo), "v"(hi)); return r; }
typedef float f32x2 __attribute__((ext_vector_type(2)));
__device__ __forceinline__ f32x2 gelu_pk(f32x2 v) {
    const f32x2 av = __builtin_elementwise_abs(v), d = av * 0.2316418882f + 1.0f;
    f32x2 t; t.x = __builtin_amdgcn_rcpf(d.x); t.y = __builtin_amdgcn_rcpf(d.y);
    f32x2 q = t * 0.5307027145f + (-0.7265760135f); q = q * t + 0.7107068705f; q = q * t + (-0.142248368f); q = q * t + 0.127414796f; q = q * t;
    const f32x2 s = (v * v) * (-0.72134752044f);
    f32x2 e; e.x = __builtin_amdgcn_exp2f(s.x); e.y = __builtin_amdgcn_exp2f(s.y);
    const f32x2 m = v * (q * e), r = v - m;
    f32x2 o; o.x = v.x < 0.f ? m.x : r.x; o.y = v.y < 0.f ? m.y : r.y; return o;
}

template <int ACT  > struct EpiBf16 {
    static constexpr bool PERM = true, AFTER_DRAIN = false; static_assert(ACT == 0 || ACT == 1, "EpiBf16: ACT is 0 (none) or 1 (gelu_pk)");
    bf16_t* O; int ldc; const float* bias; int split_cols; size_t split_stride; float scale0;
    __device__ __forceinline__ void operator()(const f32x4 (&acc)[2][2][4][2], const Unit& u, int wr, int wc, int fr, int fq) const {
        const int row0 = u.pm * BM + wr * 64 + fr; int colt = u.pn * BM; bf16_t* base = O;
        float sc = 1.f; if (split_cols) { const int t = colt / split_cols; base += (size_t)t * split_stride; colt -= t * split_cols; if (t == 0) sc = scale0; }
        const int col0 = colt + wc * 32 + 8 * fq, bcol0 = u.pn * BM + wc * 32 + 8 * fq;
        f32x4 bv[2][2];
#pragma unroll
        for (int bj = 0; bj < 2; ++bj)
#pragma unroll
            for (int n = 0; n < 2; ++n) bv[bj][n] = bias ? *(const f32x4*)(bias + bcol0 + bj * HALF + 4 * n) : (f32x4){0.f, 0.f, 0.f, 0.f};
#pragma unroll
        for (int ai = 0; ai < 2; ++ai)
#pragma unroll
            for (int m = 0; m < 4; ++m) { bf16_t* rowp = base + (size_t)(row0 + ai * HALF + m * 16) * ldc + col0;
#pragma unroll
                for (int bj = 0; bj < 2; ++bj) { f32x4 v0 = acc[ai][bj][m][0] + bv[bj][0], v1 = acc[ai][bj][m][1] + bv[bj][1];
                    if (ACT == 1) { f32x2 a = gelu_pk((f32x2){v0[0], v0[1]}), b = gelu_pk((f32x2){v0[2], v0[3]}), c = gelu_pk((f32x2){v1[0], v1[1]}), d = gelu_pk((f32x2){v1[2], v1[3]});
                        v0 = (f32x4){a.x, a.y, b.x, b.y}; v1 = (f32x4){c.x, c.y, d.x, d.y}; }
                    v0 = v0 * sc; v1 = v1 * sc; u32x4 w; w.x = cvt_pk_bf16(v0[0], v0[1]); w.y = cvt_pk_bf16(v0[2], v0[3]); w.z = cvt_pk_bf16(v1[0], v1[1]); w.w = cvt_pk_bf16(v1[2], v1[3]);
                    *(u32x4*)(rowp + bj * HALF) = w; } }
    }
};
typedef unsigned u32x2 __attribute__((ext_vector_type(2)));
__device__ __forceinline__ float bf_lo(unsigned w) { return __builtin_bit_cast(float, w << 16); }
__device__ __forceinline__ float bf_hi(unsigned w) { return __builtin_bit_cast(float, w & 0xffff0000u); }
__device__ __forceinline__ float sigmoid_f(float v) { return __builtin_amdgcn_rcpf(1.0f + __builtin_amdgcn_exp2f(-1.4426950408889634f * v)); }

template <bool LNIN> struct EpiResidLN {
    static constexpr bool PERM = false, AFTER_DRAIN = false;
    const float* Xin; float* T; const float* gate; float alpha; int ldc; const float* stat_in; const float* lng; const float* lnb; float* stat_out;
    __device__ __forceinline__ void operator()(const f32x4 (&acc)[2][2][4][2], const Unit& u, int wr, int wc, int fr, int fq) const {
        const int col0 = u.pn * BM + wc * 32 + 4 * fq;
        f32x4 gv[2][2], lg[2][2], lb[2][2];
#pragma unroll
        for (int bj = 0; bj < 2; ++bj)
#pragma unroll
            for (int n = 0; n < 2; ++n) {
                gv[bj][n] = *(const f32x4*)(gate + col0 + bj * HALF + n * 16);
                if (LNIN) { lg[bj][n] = *(const f32x4*)(lng + col0 + bj * HALF + n * 16); lb[bj][n] = *(const f32x4*)(lnb + col0 + bj * HALF + n * 16); }
            }
#pragma unroll
        for (int ai = 0; ai < 2; ++ai)
#pragma unroll
            for (int m = 0; m < 4; ++m) {
                const int row = u.pm * BM + ai * HALF + wr * 64 + m * 16 + fr;
                const size_t off = (size_t)row * ldc + col0;
                float mean = 0.f, rstd = 1.f;
                if (LNIN) { const float s1 = stat_in[2 * row], s2 = stat_in[2 * row + 1]; mean = s1 * (1.0f / 2048.0f); const float var = s2 * (1.0f / 2048.0f) - mean * mean; rstd = 1.0f / sqrtf(var + 1e-5f); }
                float s = 0.f, ss = 0.f;
#pragma unroll
                for (int bj = 0; bj < 2; ++bj)
#pragma unroll
                    for (int n = 0; n < 2; ++n) {
                        f32x4 xv = *(const f32x4*)(Xin + off + bj * HALF + n * 16);
                        if (LNIN) xv = (xv - mean) * rstd * lg[bj][n] + lb[bj][n];
                        const f32x4 o = xv * alpha + gv[bj][n] * acc[ai][bj][m][n];
                        *(f32x4*)(T + off + bj * HALF + n * 16) = o;
                        s += (o[0] + o[1]) + (o[2] + o[3]); ss += (o[0] * o[0] + o[1] * o[1]) + (o[2] * o[2] + o[3] * o[3]);
                    }
                s += __shfl_xor(s, 16); s += __shfl_xor(s, 32); ss += __shfl_xor(ss, 16); ss += __shfl_xor(ss, 32);
                if (fq == 0) { atomicAdd(stat_out + 2 * row, s); atomicAdd(stat_out + 2 * row + 1, ss); }
                asm volatile("" ::: "memory");
            }
    }
};

struct PanelOrder {
    int c;
    __host__ __device__ void init(int c_) { c = c_; }
    __host__ __device__ bool next(int i, Unit& u) const { if (i >= 2) return false; const int j = c >> 3; u.pm = 8 * (c & 7) + 4 * i + (j & 3); u.pn = j >> 2; return true; }
    __device__ __forceinline__ void a_ready(const Unit&) const {}
    __device__ __forceinline__ void done(const Unit&) const {}
};
template <bool LNIN, bool FINAL> struct EpiResidLNF {
    static constexpr bool PERM = false, AFTER_DRAIN = false;
    const float* Xin; float* T; const float* gate; float alpha; int ldc; const float* stat_in; const float* lng_in; const float* lnb_in;
    float* stat_out; unsigned* cnt; const float* lng; const float* lnb; const float* sh; const float* sc; bf16_t* H; float* OUT;
    __device__ __forceinline__ void operator()(const f32x4 (&acc_)[2][2][4][2], const Unit& u, int wr, int wc, int fr, int fq) const {
        f32x4 (&acc)[2][2][4][2] = const_cast<f32x4 (&)[2][2][4][2]>(acc_);
        asm volatile("" : "+v"(fr), "+v"(fq));
        const int col0 = u.pn * BM + wc * 32 + 4 * fq;
        {
#pragma unroll
            for (int ai = 0; ai < 2; ++ai)
#pragma unroll
                for (int m = 0; m < 4; ++m) {
                    const int row = u.pm * BM + ai * HALF + wr * 64 + m * 16 + fr;
                    const size_t off = (size_t)row * ldc + col0;
                    float mean = 0.f, rstd = 1.f;
                    if (LNIN) { const float s1 = stat_in[2 * row], s2 = stat_in[2 * row + 1]; mean = s1 * (1.0f / 2048.0f); const float var = s2 * (1.0f / 2048.0f) - mean * mean; rstd = 1.0f / sqrtf(var + 1e-5f); }
                    float s = 0.f, ss = 0.f;
#pragma unroll
                    for (int bj = 0; bj < 2; ++bj)
#pragma unroll
                        for (int n = 0; n < 2; ++n) {
                            f32x4 xv = *(const f32x4*)(Xin + off + bj * HALF + n * 16);
                            const int cc = col0 + bj * HALF + n * 16;
                            if (LNIN) xv = (xv - mean) * rstd * *(const f32x4*)(lng_in + cc) + *(const f32x4*)(lnb_in + cc);
                            const f32x4 o = xv * alpha + *(const f32x4*)(gate + cc) * acc[ai][bj][m][n];
                            acc[ai][bj][m][n] = o;
                            if (!FINAL) *(f32x4*)(T + off + bj * HALF + n * 16) = o;
                            s += (o[0] + o[1]) + (o[2] + o[3]); ss += (o[0] * o[0] + o[1] * o[1]) + (o[2] * o[2] + o[3] * o[3]);
                        }
                    s += __shfl_xor(s, 16); s += __shfl_xor(s, 32); ss += __shfl_xor(ss, 16); ss += __shfl_xor(ss, 32);
                    if (fq == 0) { atomicAdd(stat_out + 2 * row, s); atomicAdd(stat_out + 2 * row + 1, ss); }
                    if (m == 3) asm volatile("" ::: "memory");
                }
        }
        f32x4 a2[2][2], b2[2][2];
#pragma unroll
        for (int bj = 0; bj < 2; ++bj)
#pragma unroll
            for (int n = 0; n < 2; ++n) {
                const int cc = col0 + bj * HALF + n * 16;
                a2[bj][n] = *(const f32x4*)(lng + cc); b2[bj][n] = *(const f32x4*)(lnb + cc);
                if (!FINAL) { const f32x4 s1 = *(const f32x4*)(sc + cc) + 1.0f; a2[bj][n] = a2[bj][n] * s1; b2[bj][n] = b2[bj][n] * s1 + *(const f32x4*)(sh + cc); }
            }
        asm volatile("s_waitcnt vmcnt(0) lgkmcnt(0)" ::: "memory");
        unsigned* c = cnt + 64 * u.pm;
        if ((threadIdx.x & 63) == 0) __hip_atomic_fetch_add(c, 1u, __ATOMIC_RELAXED, __HIP_MEMORY_SCOPE_AGENT);
        if (__builtin_amdgcn_readfirstlane(threadIdx.x >> 6) == 0) {
            unsigned spins = 0;
            while ((unsigned)__builtin_amdgcn_readfirstlane(__hip_atomic_load(c, __ATOMIC_RELAXED, __HIP_MEMORY_SCOPE_AGENT)) < 64u) {
                __builtin_amdgcn_s_sleep(4);
                if (++spins > (1u << 23)) break;
            }
        }
        __builtin_amdgcn_s_barrier();
        asm volatile("" ::: "memory");
        float mean8[8], rstd8[8];
#pragma unroll
        for (int ai = 0; ai < 2; ++ai)
#pragma unroll
            for (int m = 0; m < 4; ++m) {
                const int row = u.pm * BM + ai * HALF + wr * 64 + m * 16 + fr;
                const float s1 = __hip_atomic_load(stat_out + 2 * row, __ATOMIC_RELAXED, __HIP_MEMORY_SCOPE_AGENT), s2 = __hip_atomic_load(stat_out + 2 * row + 1, __ATOMIC_RELAXED, __HIP_MEMORY_SCOPE_AGENT);
                const float mean = s1 * (1.0f / 2048.0f), var = s2 * (1.0f / 2048.0f) - mean * mean;
                mean8[ai * 4 + m] = mean; rstd8[ai * 4 + m] = 1.0f / sqrtf(var + 1e-5f);
            }
#pragma unroll
        for (int bj = 0; bj < 2; ++bj)
#pragma unroll
            for (int n = 0; n < 2; ++n) {
                const int cc = col0 + bj * HALF + n * 16;
#pragma unroll
                for (int ai = 0; ai < 2; ++ai)
#pragma unroll
                    for (int m = 0; m < 4; ++m) {
                        const size_t off = (size_t)(u.pm * BM + ai * HALF + wr * 64 + m * 16 + fr) * ldc + cc;
                        const f32x4 y = (acc[ai][bj][m][n] - mean8[ai * 4 + m]) * rstd8[ai * 4 + m] * a2[bj][n] + b2[bj][n];
                        if (FINAL) *(f32x4*)(OUT + off) = y;
                        else { u32x2 w; w.x = cvt_pk_bf16(y[0], y[1]); w.y = cvt_pk_bf16(y[2], y[3]); *(u32x2*)(H + off) = w; }
                    }
                asm volatile("" ::: "memory");
            }
    }
};

struct EpiSwiglu {
    static constexpr bool PERM = true, AFTER_DRAIN = false;
    bf16_t* O; int ldo;
    __device__ __forceinline__ void operator()(const f32x4 (&acc)[2][2][4][2], const Unit& u, int wr, int wc, int fr, int fq) const {
        const int row0 = u.pm * BM + wr * 64 + fr, col0 = u.pn * HALF + wc * 32 + 8 * fq;
#pragma unroll
        for (int ai = 0; ai < 2; ++ai)
#pragma unroll
            for (int m = 0; m < 4; ++m) {
                bf16_t* rowp = O + (size_t)(row0 + ai * HALF + m * 16) * ldo + col0;
                float v[8];
#pragma unroll
                for (int n = 0; n < 2; ++n)
#pragma unroll
                    for (int i = 0; i < 4; ++i) { const float gt = acc[ai][0][m][n][i], up = acc[ai][1][m][n][i]; v[4 * n + i] = gt * sigmoid_f(gt) * up; }
                u32x4 w; w.x = cvt_pk_bf16(v[0], v[1]); w.y = cvt_pk_bf16(v[2], v[3]); w.z = cvt_pk_bf16(v[4], v[5]); w.w = cvt_pk_bf16(v[6], v[7]);
                *(u32x4*)rowp = w;
            }
    }
};

struct EpiGlu {
    static constexpr bool PERM = true, AFTER_DRAIN = false;
    const bf16_t* S; int lds_; const float* b; bf16_t* O; int ldo; int ocol0;
    __device__ __forceinline__ void operator()(const f32x4 (&acc)[2][2][4][2], const Unit& u, int wr, int wc, int fr, int fq) const {
        const int row0 = u.pm * BM + wr * 64 + fr, col0 = u.pn * BM + wc * 32 + 8 * fq;
        f32x4 bv[2][2];
#pragma unroll
        for (int bj = 0; bj < 2; ++bj)
#pragma unroll
            for (int n = 0; n < 2; ++n) bv[bj][n] = *(const f32x4*)(b + col0 + bj * HALF + 4 * n);
#pragma unroll
        for (int ai = 0; ai < 2; ++ai)
#pragma unroll
            for (int m = 0; m < 4; ++m) {
                const size_t row = (size_t)(row0 + ai * HALF + m * 16);
#pragma unroll
                for (int bj = 0; bj < 2; ++bj) {
                    const u32x4 sw = *(const u32x4*)(S + row * lds_ + col0 + bj * HALF);
                    const f32x4 z0 = acc[ai][bj][m][0] + bv[bj][0], z1 = acc[ai][bj][m][1] + bv[bj][1];
                    u32x4 w;
                    w.x = cvt_pk_bf16(bf_lo(sw.x) * sigmoid_f(z0[0]), bf_hi(sw.x) * sigmoid_f(z0[1]));
                    w.y = cvt_pk_bf16(bf_lo(sw.y) * sigmoid_f(z0[2]), bf_hi(sw.y) * sigmoid_f(z0[3]));
                    w.z = cvt_pk_bf16(bf_lo(sw.z) * sigmoid_f(z1[0]), bf_hi(sw.z) * sigmoid_f(z1[1]));
                    w.w = cvt_pk_bf16(bf_lo(sw.w) * sigmoid_f(z1[2]), bf_hi(sw.w) * sigmoid_f(z1[3]));
                    *(u32x4*)(O + row * ldo + ocol0 + col0 + bj * HALF) = w;
                }
                asm volatile("" ::: "memory");
            }
    }
};

struct EpiQKRot {
    static constexpr bool PERM = true, AFTER_DRAIN = false;
    bf16_t* O0; int ld0; int nt0; float scale0; bf16_t* O1; int ld1; const float* COS; const float* SIN;
    __device__ __forceinline__ void operator()(const f32x4 (&acc)[2][2][4][2], const Unit& u, int wr, int wc, int fr, int fq) const {
        const int row0 = u.pm * BM + wr * 64 + fr;
        const bool first = u.pn < nt0;
        bf16_t* base = first ? O0 : O1; const int ld = first ? ld0 : ld1; const float sc = first ? scale0 : 1.0f;
        const int col0 = (first ? u.pn : u.pn - nt0) * BM + wc * 32 + 8 * fq;
        const bool rotw = (wc & 1) == 0;
#pragma unroll
        for (int ai = 0; ai < 2; ++ai)
#pragma unroll
            for (int m = 0; m < 4; ++m) {
                const size_t row = (size_t)(row0 + ai * HALF + m * 16);
                f32x4 cs[2], sn[2];
                if (rotw) {
#pragma unroll
                    for (int n = 0; n < 2; ++n) { cs[n] = *(const f32x4*)(COS + row * 8 + 4 * n); sn[n] = *(const f32x4*)(SIN + row * 8 + 4 * n); }
                }
#pragma unroll
                for (int bj = 0; bj < 2; ++bj) {
                    f32x4 v0 = acc[ai][bj][m][0], v1 = acc[ai][bj][m][1];
                    if (rotw) {
                        f32x4 p0, p1;
#pragma unroll
                        for (int i = 0; i < 4; ++i) { p0[i] = __shfl_xor(v0[i], 16); p1[i] = __shfl_xor(v1[i], 16); }
                        if (fq == 0) { v0 = v0 * cs[0] - p0 * sn[0]; v1 = v1 * cs[1] - p1 * sn[1]; }
                        else if (fq == 1) { v0 = v0 * cs[0] + p0 * sn[0]; v1 = v1 * cs[1] + p1 * sn[1]; }
                    }
                    v0 = v0 * sc; v1 = v1 * sc;
                    u32x4 w; w.x = cvt_pk_bf16(v0[0], v0[1]); w.y = cvt_pk_bf16(v0[2], v0[3]); w.z = cvt_pk_bf16(v1[0], v1[1]); w.w = cvt_pk_bf16(v1[2], v1[3]);
                    *(u32x4*)(base + row * ld + col0 + bj * HALF) = w;
                }
                asm volatile("" ::: "memory");
            }
    }
};
template <class Epi, class Sched, bool ALIGN_EPI = false, bool SP2 = false>
__device__ __forceinline__ void gemm_phase(PG8_LAS unsigned char* lds, const Gemm g, const Sched& S, const Epi& E) {
    int tid_ = threadIdx.x; asm volatile("" : "+v"(tid_));
    const int tid = tid_, wid = __builtin_amdgcn_readfirstlane(tid >> 6), lane = tid & 63, wr = wid >> 2, wc = wid & 3, fr = lane & 15, fq = lane >> 4;
    const int K = g.K, nt = K / BK;
    unsigned voffA[2], voffB[2];
#pragma unroll
    for (int i = 0; i < 2; ++i) { int R, C; stage_rc(tid * 16 + i * 8192, R, C); const int Rb = Epi::PERM ? ((R & ~31) + perm32(R & 31)) : R;
        voffA[i] = (unsigned)(R * K + C) * 2u; voffB[i] = (unsigned)(Rb * K + C) * 2u; }
    const size_t kstep = (size_t)(BK * 2);
    const size_t hstep = (size_t)HALF * K * 2;
    const size_t tstep = 2 * hstep;
    const unsigned ldsw = (unsigned)wid * 1024u;
    const int aoff = lds_byte(wr * 64 + fr, fq * 8), boff = lds_byte(wc * 32 + fr, fq * 8);
#define PG8_SA(b, h) (((b) * 2 + (h)) * HTB)
#define PG8_SB(b, h) ((4 + (b) * 2 + (h)) * HTB)
#define PG8_STAGE(bufoff, gbase, voff) do { _Pragma("unroll") for (int _i = 0; _i < 2; ++_i) \
        __builtin_amdgcn_global_load_lds((const unsigned*)((const char*)(gbase) + (voff)[_i]), (PG8_LAS unsigned*)(lds + (bufoff) + ldsw + _i * 8192), 16, 0, 0); } while (0)
#define PG8_LDA(dst, b, h) do { _Pragma("unroll") for (int m = 0; m < 4; ++m) _Pragma("unroll") for (int k = 0; k < 2; ++k) dst[m][k] = *(const PG8_LAS bf16x8*)(lds + PG8_SA(b, h) + aoff + m * 2048 + k * 1024); } while (0)
#define PG8_LDB(dst, b, h) do { _Pragma("unroll") for (int n = 0; n < 2; ++n) _Pragma("unroll") for (int k = 0; k < 2; ++k) dst[n][k] = *(const PG8_LAS bf16x8*)(lds + PG8_SB(b, h) + boff + n * 2048 + k * 1024); } while (0)
#define PG8_MMA(ai, bj, At, Bt) do { __builtin_amdgcn_s_setprio(1); _Pragma("unroll") for (int m = 0; m < 4; ++m) _Pragma("unroll") for (int n = 0; n < 2; ++n) _Pragma("unroll") for (int k = 0; k < 2; ++k) \
        acc[ai][bj][m][n] = __builtin_amdgcn_mfma_f32_16x16x32_bf16(Bt[n][k], At[m][k], acc[ai][bj][m][n], 0, 0, 0); __builtin_amdgcn_s_setprio(0); } while (0)
#define PG8_WAIT_V(n) asm volatile("s_waitcnt vmcnt(" #n ")" ::: "memory")
#define PG8_WAIT_L(n) asm volatile("s_waitcnt lgkmcnt(" #n ")" ::: "memory")
#define PG8_BAR __builtin_amdgcn_s_barrier()
#define PG8_SCHED __builtin_amdgcn_sched_barrier(0)
    Unit cur, nxt; int ui = 0;
    if (!S.next(0, cur)) return;
    f32x4 acc[2][2][4][2];
#pragma unroll
    for (int a = 0; a < 2; ++a)
#pragma unroll
        for (int b = 0; b < 2; ++b)
#pragma unroll
            for (int m = 0; m < 4; ++m)
#pragma unroll
                for (int n = 0; n < 2; ++n) acc[a][b][m][n] = (f32x4){0.f, 0.f, 0.f, 0.f};
    bf16x8 At[4][2], B0[2][2], B1[2][2];
    const char* cA = (const char*)g.A + (size_t)cur.pm * tstep; const char* cB = (const char*)g.Bt + (size_t)cur.pn * tstep;
    S.a_ready(cur);
    if constexpr (SP2) {
        PG8_STAGE(PG8_SB(0, 0), cB, voffB); PG8_STAGE(PG8_SB(0, 1), cB + hstep, voffB); PG8_STAGE(PG8_SA(0, 0), cA, voffA); PG8_STAGE(PG8_SA(0, 1), cA + hstep, voffA);
        if (wr == 1) PG8_BAR;
        PG8_WAIT_V(2); PG8_BAR;
        PG8_STAGE(PG8_SB(1, 0), cB + kstep, voffB); PG8_STAGE(PG8_SA(1, 0), cA + kstep, voffA); PG8_STAGE(PG8_SB(1, 1), cB + hstep + kstep, voffB);
        PG8_WAIT_V(6); PG8_BAR;
    } else {
        PG8_STAGE(PG8_SB(0, 0), cB, voffB); PG8_STAGE(PG8_SA(0, 0), cA, voffA); PG8_STAGE(PG8_SB(0, 1), cB + hstep, voffB); PG8_STAGE(PG8_SA(0, 1), cA + hstep, voffA);
        if (wr == 1) PG8_BAR;
        PG8_WAIT_V(4); PG8_BAR;
        PG8_STAGE(PG8_SB(1, 0), cB + kstep, voffB); PG8_STAGE(PG8_SA(1, 0), cA + kstep, voffA); PG8_STAGE(PG8_SB(1, 1), cB + hstep + kstep, voffB);
        PG8_WAIT_V(6); PG8_BAR;
    }
    for (;;) {
        const bool has_next = S.next(ui + 1, nxt);
        const char* nA = has_next ? (const char*)g.A + (size_t)nxt.pm * tstep : cA; const char* nB = has_next ? (const char*)g.Bt + (size_t)nxt.pn * tstep : cB;
        for (int t = 0; t < nt; t += 2) {
            const bool last = (t == nt - 2);
            const char* a1 = cA + (size_t)(t + 1) * kstep;
            const char* a2 = last ? nA : cA + (size_t)(t + 2) * kstep; const char* b2 = last ? nB : cB + (size_t)(t + 2) * kstep;
            const char* a3 = a2 + kstep; const char* b3 = b2 + kstep;
            if (last && has_next) S.a_ready(nxt);
            if constexpr (SP2) {
            PG8_LDB(B0, 0, 0); PG8_LDB(B1, 0, 1); PG8_SCHED; PG8_LDA(At, 0, 0); PG8_STAGE(PG8_SA(1, 1), a1 + hstep, voffA);
            PG8_WAIT_V(8); PG8_WAIT_L(0); PG8_BAR; PG8_MMA(0, 0, At, B0); PG8_MMA(0, 1, At, B1); PG8_BAR; PG8_SCHED;
            PG8_LDA(At, 0, 1); PG8_STAGE(PG8_SB(0, 0), b2, voffB); PG8_STAGE(PG8_SB(0, 1), b2 + hstep, voffB); PG8_STAGE(PG8_SA(0, 0), a2, voffA);
            PG8_WAIT_V(8); PG8_WAIT_L(0); PG8_BAR; PG8_MMA(1, 0, At, B0); PG8_MMA(1, 1, At, B1); PG8_BAR; PG8_SCHED;
            PG8_LDB(B0, 1, 0); PG8_LDB(B1, 1, 1); PG8_SCHED; PG8_LDA(At, 1, 0); PG8_STAGE(PG8_SA(0, 1), a2 + hstep, voffA);
            PG8_WAIT_V(8); PG8_WAIT_L(0); PG8_BAR; PG8_MMA(0, 0, At, B0); PG8_MMA(0, 1, At, B1); PG8_BAR; PG8_SCHED;
            PG8_LDA(At, 1, 1); PG8_STAGE(PG8_SB(1, 0), b3, voffB); PG8_STAGE(PG8_SB(1, 1), b3 + hstep, voffB); PG8_STAGE(PG8_SA(1, 0), a3, voffA);
            PG8_WAIT_V(8); PG8_WAIT_L(0); PG8_BAR; PG8_MMA(1, 0, At, B0); PG8_MMA(1, 1, At, B1); PG8_BAR; PG8_SCHED;
            } else {
            PG8_LDB(B0, 0, 0); PG8_SCHED; PG8_LDA(At, 0, 0); PG8_STAGE(PG8_SA(1, 1), a1 + hstep, voffA);
            PG8_WAIT_L(8); PG8_BAR; PG8_WAIT_L(0); PG8_MMA(0, 0, At, B0); PG8_BAR; PG8_SCHED;
            PG8_LDB(B1, 0, 1); PG8_STAGE(PG8_SB(0, 0), b2, voffB);
            PG8_BAR; PG8_WAIT_L(0); PG8_MMA(0, 1, At, B1); PG8_BAR;
            PG8_LDA(At, 0, 1); PG8_STAGE(PG8_SA(0, 0), a2, voffA);
            PG8_BAR; PG8_WAIT_L(0); PG8_MMA(1, 0, At, B0); PG8_BAR; PG8_SCHED;
            PG8_STAGE(PG8_SB(0, 1), b2 + hstep, voffB);
            PG8_WAIT_V(6); PG8_BAR; PG8_MMA(1, 1, At, B1); PG8_BAR;
            PG8_LDB(B0, 1, 0); PG8_SCHED; PG8_LDA(At, 1, 0); PG8_STAGE(PG8_SA(0, 1), a2 + hstep, voffA);
            PG8_WAIT_L(8); PG8_BAR; PG8_WAIT_L(0); PG8_MMA(0, 0, At, B0); PG8_BAR; PG8_SCHED;
            PG8_LDB(B1, 1, 1); PG8_STAGE(PG8_SB(1, 0), b3, voffB);
            PG8_BAR; PG8_WAIT_L(0); PG8_MMA(0, 1, At, B1); PG8_BAR;
            PG8_LDA(At, 1, 1); PG8_STAGE(PG8_SA(1, 0), a3, voffA);
            PG8_BAR; PG8_WAIT_L(0); PG8_MMA(1, 0, At, B0); PG8_BAR; PG8_SCHED;
            PG8_STAGE(PG8_SB(1, 1), b3 + hstep, voffB);
            PG8_WAIT_V(6); PG8_BAR; PG8_MMA(1, 1, At, B1); PG8_BAR;
            }
        }
        if constexpr (ALIGN_EPI) { if (wr == 0) PG8_BAR; }
        if constexpr (!Epi::AFTER_DRAIN) { E(acc, cur, wr, wc, fr, fq); S.done(cur); }
        if (!has_next) break;
#pragma unroll
        for (int a = 0; a < 2; ++a)
#pragma unroll
            for (int b = 0; b < 2; ++b)
#pragma unroll
                for (int m = 0; m < 4; ++m)
#pragma unroll
                    for (int n = 0; n < 2; ++n) acc[a][b][m][n] = (f32x4){0.f, 0.f, 0.f, 0.f};
        cur = nxt; cA = nA; cB = nB; ++ui;
        if constexpr (ALIGN_EPI) { if (wr == 1) PG8_BAR; }
    }
    PG8_WAIT_V(0);
    if constexpr (!ALIGN_EPI) { if (wr == 0) PG8_BAR; }
    PG8_BAR;
    if constexpr (Epi::AFTER_DRAIN) { E.fused(acc, cur, wr, wc, fr, fq, lds, wid, lane); S.done(cur); }
#undef PG8_SA
#undef PG8_SB
#undef PG8_STAGE
#undef PG8_LDA
#undef PG8_LDB
#undef PG8_MMA
#undef PG8_WAIT_V
#undef PG8_WAIT_L
#undef PG8_BAR
#undef PG8_SCHED
}
}
#define LAS __attribute__((address_space(3)))
typedef unsigned short bf16;
typedef float f32x4 __attribute__((ext_vector_type(4)));
typedef float f32x2 __attribute__((ext_vector_type(2)));
typedef float f32x16 __attribute__((ext_vector_type(16)));
typedef short bf16x8 __attribute__((ext_vector_type(8)));
typedef short s16x4 __attribute__((ext_vector_type(4)));
typedef unsigned u32x4 __attribute__((ext_vector_type(4)));
typedef unsigned u32x2 __attribute__((ext_vector_type(2)));

constexpr int M = 16384, DM = 2048, FW = 1024, EVEN_IN = 4104, ODD_IN = 2560, KVW = 256, DFF = 5632;
constexpr int NWAVES = 8, NTHR = 512;
constexpr float LN_EPS = 1e-5f;
constexpr float ALPHA = 1.4142135623730951f;
constexpr float LOG2E = 1.4426950408889634f;
constexpr int LDS_BYTES = 147456;
constexpr int LDS_BARST = LDS_BYTES - 16;
#define VCU(lds) (((volatile LAS unsigned*)((lds) + LDS_BARST))[2])

constexpr size_t MiB = 1u << 20;
constexpr size_t WS_MOD = 0;
constexpr size_t CTL_ZERO_BYTES = 2 * MiB;
constexpr size_t WS_PCNT = 1 * MiB + 512 * 1024;
constexpr size_t WS_STAT = 1 * MiB;
constexpr int CW_KMAX2 = 24576, CW_QN2 = 24640;
constexpr size_t WS_W1T = 2 * MiB, WS_WVT = 14 * MiB, WS_WGLU = 18 * MiB, WS_WOUT = 20 * MiB, WS_WC1T = 28 * MiB, WS_WCVT = 38 * MiB, WS_WOC = 40 * MiB;
constexpr size_t WS_WGU0 = 48 * MiB, WS_WGU1 = 92 * MiB, WS_WD0 = 136 * MiB, WS_WD1 = 158 * MiB;
constexpr size_t WS_H = 180 * MiB;
constexpr size_t WS_R = 244 * MiB;
constexpr size_t WS_Q = WS_R, WS_K = WS_R + 32 * MiB, WS_U = WS_R + 64 * MiB, WS_VT = WS_R + 96 * MiB, WS_S = WS_R + 128 * MiB, WS_MIX = WS_R + 160 * MiB;
constexpr size_t WS_MID = WS_R;
constexpr size_t WS_Q2 = WS_R, WS_K2 = WS_R + 64 * MiB, WS_VT2 = WS_R + 72 * MiB;
constexpr size_t WS_E = 468 * MiB;
constexpr size_t WS_LOGF = 476 * MiB, WS_F = WS_LOGF + MiB / 2, WS_COS = 477 * MiB, WS_SIN = WS_COS + MiB / 2;
constexpr size_t WS_END = 478 * MiB;

struct TDesc { const float* src; bf16* dst; int ld, K, ncols, mode, row_off, first; };
constexpr int NTD = 14;
struct Params {
    const float *x, *c; const int* pos;
    const float *w_in_ab, *b_forget, *lam_re, *lam_im, *log_dt, *b_re, *b_im, *c_re, *c_im, *ssm_d, *w_glu, *b_glu, *w_out_ab, *w_in_c, *sinks, *w_out_c,
        *w_ada, *b_ada, *ln_mix_g, *ln_mix_b, *ln_ffn_g, *ln_ffn_b, *w_gate, *w_up, *w_down;
    float* out; unsigned char* ws;
    TDesc td[NTD]; int n_items; int n_items_p0;
};

__device__ __forceinline__ unsigned f2bf(float f) { unsigned u = __builtin_bit_cast(unsigned, f); return (u + 0x7fffu + ((u >> 16) & 1u)) >> 16; }
__device__ __forceinline__ unsigned pk2(float lo, float hi) { return f2bf(lo) | (f2bf(hi) << 16); }
__device__ __forceinline__ float bflo(unsigned w) { return __builtin_bit_cast(float, w << 16); }
__device__ __forceinline__ float bfhi(unsigned w) { return __builtin_bit_cast(float, w & 0xffff0000u); }
__device__ __forceinline__ float wave_sum(float v) {
#pragma unroll
    for (int o = 1; o < 64; o <<= 1) v += __shfl_xor(v, o);
    return v;
}
__device__ __forceinline__ void sincos_d(double ang, double& s, double& c) {
    const double TWO_PI = 6.283185307179586476925287, INV_TWO_PI = 0.159154943091895335768884;
    const double k = __builtin_rint(ang * INV_TWO_PI);
    const double r = __builtin_fma(-k, TWO_PI, ang) - k * 2.449293598294706e-16;
    const double r2 = r * r;
    double ss = 1.0 / 1.0888869450418352e28;
    double cc = 1.0 / 4.0329146112660565e26;
    const double fs[13] = {1.0 / 1.5511210043330986e25, 1.0 / 2.5852016738884978e22, 1.0 / 5.109094217170944e19, 1.0 / 1.21645100408832e17, 1.0 / 355687428096000.0, 1.0 / 1307674368000.0,
                           1.0 / 6227020800.0, 1.0 / 39916800.0, 1.0 / 362880.0, 1.0 / 5040.0, 1.0 / 120.0, 1.0 / 6.0, 1.0};
    const double fc[13] = {1.0 / 6.204484017332394e23, 1.0 / 1.1240007277776077e21, 1.0 / 2.43290200817664e18, 1.0 / 6402373705728000.0, 1.0 / 20922789888000.0, 1.0 / 87178291200.0,
                           1.0 / 479001600.0, 1.0 / 3628800.0, 1.0 / 40320.0, 1.0 / 720.0, 1.0 / 24.0, 1.0 / 2.0, 1.0};
#pragma unroll
    for (int i = 0; i < 13; ++i) { ss = fs[i] - ss * r2; cc = fc[i] - cc * r2; }
    s = ss * r; c = cc;
}

__device__ __forceinline__ void transpose_item(const TDesc& d, LAS float* scr, int item, int lane) {
    const int nblk = d.ncols / 32, kb = item / nblk, nb = item % nblk, k0 = 64 * kb, n0 = 32 * nb;
    const float* W = d.src;
#pragma unroll 16
    for (int i = 0; i < 32; ++i) { const int kk = 2 * i + (lane >> 5); scr[kk * 33 + (lane & 31)] = W[(size_t)(k0 + kk) * d.ld + n0 + (lane & 31)]; }
    asm volatile("s_waitcnt lgkmcnt(0)" ::: "memory");
    const int c = lane & 7;
    const int drow0 = (d.mode == 0) ? (d.row_off + n0) : ((n0 >> 7) * 256 + (n0 & 127) + d.row_off);
#pragma unroll
    for (int j = 0; j < 4; ++j) { const int n = (lane >> 3) + 8 * j; const LAS float* s = scr + (8 * c) * 33 + n;
        u32x4 o; o.x = pk2(s[0 * 33], s[1 * 33]); o.y = pk2(s[2 * 33], s[3 * 33]); o.z = pk2(s[4 * 33], s[5 * 33]); o.w = pk2(s[6 * 33], s[7 * 33]);
        *(u32x4*)(d.dst + (size_t)(drow0 + n) * d.K + k0 + 8 * c) = o; }
    asm volatile("s_waitcnt lgkmcnt(0)" ::: "memory");
}

__device__ __forceinline__ void convert_items(const Params& P, LAS float* scr, int it_lo, int it_hi, int w, int nw, int lane) {
    for (int it = it_lo + w; it < it_hi; it += nw) {
        int di = 0;
#pragma unroll
        for (int j = 1; j < NTD; ++j) di = (it >= P.td[j].first) ? j : di;
        const TDesc d = P.td[di];
        transpose_item(d, scr, it - d.first, lane);
    }
}
__device__ __forceinline__ void p0_prologue(const Params& P, LAS unsigned char* lds, int wave, int lane) {
    LAS float* scr = (LAS float*)(lds + wave * 16384);
    const int gw = blockIdx.x * NWAVES + wave, NGW = gridDim.x * NWAVES;
    float* mod = (float*)(P.ws + WS_MOD);
    for (int it = gw; it < 96 * 32; it += NGW) {
        const int nb = it % 96, ks = it / 96, l = nb / 48, n0 = (nb % 48) * 256 + 4 * lane;
        const float* W = P.w_ada + ((size_t)l * DM + ks * 64) * 12288 + n0;
        f32x4 acc = {0.f, 0.f, 0.f, 0.f};
#pragma unroll 16
        for (int k = 0; k < 64; ++k) { const float cv = P.c[ks * 64 + k]; const float sv = cv * __builtin_amdgcn_rcpf(1.0f + __expf(-cv)); const f32x4 w = *(const f32x4*)(W + (size_t)k * 12288); acc += w * sv; }
        if (ks == 0) acc += *(const f32x4*)(P.b_ada + l * 12288 + n0);
        float* o = mod + l * 12288 + n0;
        atomicAdd(o + 0, acc[0]); atomicAdd(o + 1, acc[1]); atomicAdd(o + 2, acc[2]); atomicAdd(o + 3, acc[3]);
    }
    {
        float* COS = (float*)(P.ws + WS_COS); float* SIN = (float*)(P.ws + WS_SIN);
        const double inv_freq[8] = {1.0, 0.19392274474868576, 0.03760603093086393, 0.007292664737217109, 0.001414213562373095, 0.0002742481756762073, 5.318295896944988e-05, 1.031338537721246e-05};
        for (int e = blockIdx.x * NTHR + threadIdx.x; e < M * 8; e += gridDim.x * NTHR) {
            const int t = e >> 3, i = e & 7;
            double fr = inv_freq[0];
#pragma unroll
            for (int j = 1; j < 8; ++j) fr = (i == j) ? inv_freq[j] : fr;
            const double ang = (double)P.pos[t] * fr;
            double s, c; sincos_d(ang, s, c);
            COS[e] = (float)c; SIN[e] = (float)s;
        }
    }
    convert_items(P, scr, 0, P.n_items_p0, gw, NGW, lane);
}

__device__ __forceinline__ float log_sigmoid_f(float z) { return (z >= 0.f) ? -log1pf(__expf(-z)) : (z - log1pf(__expf(z))); }
__device__ __forceinline__ void hprep_phase(const Params& P, LAS unsigned char* lds, int wave, int lane) {
    LAS float* SC1 = (LAS float*)lds; LAS float* SH = SC1 + DM; LAS float* WF = SH + DM;
    const float* mod = (const float*)(P.ws + WS_MOD);
    for (int i = threadIdx.x; i < DM; i += NTHR) { SH[i] = mod[i]; SC1[i] = 1.0f + mod[DM + i]; }
    for (int i = threadIdx.x; i < DM * 8; i += NTHR) WF[(i & 7) * DM + (i >> 3)] = P.w_in_ab[(size_t)(i >> 3) * EVEN_IN + 3 * FW + (i & 7)];
    __syncthreads();
    bf16* H = (bf16*)(P.ws + WS_H); float* LOGF = (float*)(P.ws + WS_LOGF);
    const int gw = blockIdx.x * NWAVES + wave, NGW = gridDim.x * NWAVES;
    for (int m = gw; m < M; m += NGW) {
        const f32x4* xr = (const f32x4*)(P.x + (size_t)m * DM) + lane;
        float fl[8];
#pragma unroll
        for (int j = 0; j < 8; ++j) fl[j] = 0.f;
        unsigned long long* o8 = (unsigned long long*)(H + (size_t)m * DM) + lane;
        f32x4 xv[8];
#pragma unroll
        for (int j = 0; j < 8; ++j) xv[j] = xr[64 * j];
#pragma unroll 2
        for (int j = 0; j < 8; ++j) {
            f32x4 v = xv[j];
            const f32x4 s1 = *(const LAS f32x4*)(SC1 + 4 * lane + 256 * j), sh = *(const LAS f32x4*)(SH + 4 * lane + 256 * j);
            v = v * s1 + sh;
            o8[64 * j] = (unsigned long long)pk2(v[0], v[1]) | ((unsigned long long)pk2(v[2], v[3]) << 32);
#pragma unroll
            for (int jf = 0; jf < 8; ++jf) {
                const f32x4 w = *(const LAS f32x4*)(WF + jf * DM + 4 * lane + 256 * j);
                fl[jf] += (v[0] * w[0] + v[1] * w[1]) + (v[2] * w[2] + v[3] * w[3]);
            }
        }
#pragma unroll
        for (int j = 0; j < 8; ++j) fl[j] = wave_sum(fl[j]);
        if (lane < 8) {
            float z = fl[0];
#pragma unroll
            for (int j = 1; j < 8; ++j) z = (lane == j) ? fl[j] : z;
            z += P.b_forget[lane];
            LOGF[(size_t)lane * M + m] = log_sigmoid_f(z);
        }
    }
    __syncthreads();
}

__device__ __forceinline__ void cumsum_phase(const Params& P, LAS unsigned char* lds, int wave, int lane) {
    const float* LOGF = (const float*)(P.ws + WS_LOGF); float* F = (float*)(P.ws + WS_F);
    LAS double* WT = (LAS double*)lds;
    for (int head = blockIdx.x; head < 8; head += gridDim.x) {
        const int t0 = threadIdx.x * 32;
        f32x4 lv[8];
#pragma unroll
        for (int i = 0; i < 8; ++i) lv[i] = *(const f32x4*)(LOGF + (size_t)head * M + t0 + 4 * i);
        double loc = 0.0;
#pragma unroll
        for (int i = 0; i < 8; ++i) loc += ((double)lv[i][0] + (double)lv[i][1]) + ((double)lv[i][2] + (double)lv[i][3]);
        double sc = loc;
#pragma unroll
        for (int o = 1; o < 64; o <<= 1) { const double n = __shfl_up(sc, o); if (lane >= o) sc += n; }
        if (lane == 63) WT[wave] = sc;
        __syncthreads();
        double base = sc - loc;
#pragma unroll
        for (int w = 0; w < NWAVES; ++w) base += (w < wave) ? WT[w] : 0.0;
        double run = base;
#pragma unroll
        for (int i = 0; i < 8; ++i) { f32x4 o;
#pragma unroll
            for (int e = 0; e < 4; ++e) { run += (double)lv[i][e]; o[e] = (float)run; }
            *(f32x4*)(F + (size_t)head * M + t0 + 4 * i) = o; }
        __syncthreads();
    }
}

__device__ __forceinline__ void ln_phase(float* T, const float* g, const float* b, const float* sh, const float* sc, bf16* H, LAS unsigned char* lds, int wave, int lane) {
    LAS float* G = (LAS float*)lds; LAS float* B = G + DM; LAS float* SC1 = B + DM; LAS float* SH = SC1 + DM;
    for (int i = threadIdx.x; i < DM; i += NTHR) { G[i] = g[i]; B[i] = b[i]; SC1[i] = sc ? 1.0f + sc[i] : 1.0f; SH[i] = sh ? sh[i] : 0.f; }
    __syncthreads();
    const int gw = blockIdx.x * NWAVES + wave, NGW = gridDim.x * NWAVES;
    for (int m = gw; m < M; m += NGW) {
        f32x4* xr = (f32x4*)(T + (size_t)m * DM) + lane;
        f32x4 v[8]; float s = 0.f;
#pragma unroll
        for (int j = 0; j < 8; ++j) { v[j] = xr[64 * j]; s += (v[j][0] + v[j][1]) + (v[j][2] + v[j][3]); }
        const float mean = wave_sum(s) * (1.f / DM); float s2 = 0.f;
#pragma unroll
        for (int j = 0; j < 8; ++j) { v[j] = v[j] - mean; s2 += (v[j][0] * v[j][0] + v[j][1] * v[j][1]) + (v[j][2] * v[j][2] + v[j][3] * v[j][3]); }
        const float rstd = 1.f / sqrtf(wave_sum(s2) * (1.f / DM) + LN_EPS);
#pragma unroll
        for (int j = 0; j < 8; ++j) {
            const f32x4 gg = *(const LAS f32x4*)(G + 4 * lane + 256 * j), bb = *(const LAS f32x4*)(B + 4 * lane + 256 * j);
            const f32x4 y = v[j] * rstd * gg + bb;
            xr[64 * j] = y;
            if (H) {
                const f32x4 s1 = *(const LAS f32x4*)(SC1 + 4 * lane + 256 * j), hh = *(const LAS f32x4*)(SH + 4 * lane + 256 * j);
                const f32x4 h = y * s1 + hh;
                ((unsigned long long*)(H + (size_t)m * DM) + lane)[64 * j] = (unsigned long long)pk2(h[0], h[1]) | ((unsigned long long)pk2(h[2], h[3]) << 32);
            }
        }
    }
    __syncthreads();
}

__device__ __forceinline__ void ln_apply_phase(const float* T, const float* stat, const float* g, const float* b, const float* sh, const float* sc, bf16* H, float* OUT,
                                               LAS unsigned char* lds, int wave, int lane) {
    LAS float* A = (LAS float*)lds; LAS float* B = A + DM;
    for (int i = threadIdx.x; i < DM; i += NTHR) { const float s1 = sc ? 1.0f + sc[i] : 1.0f; A[i] = g[i] * s1; B[i] = b[i] * s1 + (sh ? sh[i] : 0.f); }
    __syncthreads();
    const int gw = blockIdx.x * NWAVES + wave, NGW = gridDim.x * NWAVES;
    f32x4 av[8], bv[8];
#pragma unroll
    for (int j = 0; j < 8; ++j) { av[j] = *(const LAS f32x4*)(A + 4 * lane + 256 * j); bv[j] = *(const LAS f32x4*)(B + 4 * lane + 256 * j); }
#pragma unroll 2
    for (int m = gw; m < M; m += NGW) {
        const f32x4* xr = (const f32x4*)(T + (size_t)m * DM) + lane;
        f32x4 v[8];
#pragma unroll
        for (int j = 0; j < 8; ++j) v[j] = xr[64 * j];
        const float s1 = stat[2 * m], s2 = stat[2 * m + 1];
        const float mean = s1 * (1.0f / DM), var = s2 * (1.0f / DM) - mean * mean, rstd = 1.0f / sqrtf(var + LN_EPS);
#pragma unroll
        for (int j = 0; j < 8; ++j) {
            const f32x4 y = (v[j] - mean) * rstd * av[j] + bv[j];
            if (H) ((unsigned long long*)(H + (size_t)m * DM) + lane)[64 * j] = (unsigned long long)pk2(y[0], y[1]) | ((unsigned long long)pk2(y[2], y[3]) << 32);
            if (OUT) ((f32x4*)(OUT + (size_t)m * DM) + lane)[64 * j] = y;
        }
    }
    __syncthreads();
}

template <int D> struct AttnL { static constexpr int KP = D * 2 + 16, VP = 144, KBYTES = 64 * KP, VBYTES = D * VP, BIAS_OFF = KBYTES + VBYTES, BUF = BIAS_OFF + 256; };
__device__ __forceinline__ unsigned cvtpk(float lo, float hi) { unsigned r; asm volatile("v_cvt_pk_bf16_f32 %0, %1, %2" : "=v"(r) : "v"(lo), "v"(hi)); return r; }

#ifndef ATT_KDB
#define ATT_KDB 0
#endif
#ifndef ATT_VDB
#define ATT_VDB 0
#endif
template <int D, bool BIAS, bool NOMAX>
__device__ __forceinline__ void attn_tile(const LAS unsigned char* buf, const bf16x8 (&Qf)[D / 16], f32x16 (&o)[D / 32], float& m, float& l, float rowc, int dq, unsigned W, bool need_mask, int lane) {
    typedef AttnL<D> L;
    const int r32 = lane & 31, hh = lane >> 5;
    constexpr int GPB = (D / 16) / 4, NKG = 2 * GPB;
    constexpr int NDB = D / 32;
    f32x16 p[2];
    bf16x8 kf[2][4];
    const LAS unsigned char* kbase = buf + r32 * L::KP + 16 * hh;
#define AT_KLOAD(gi, dst) do { _Pragma("unroll") for (int j_ = 0; j_ < 4; ++j_) \
        dst[j_] = *(const LAS bf16x8*)(kbase + (32 * ((gi) / GPB)) * L::KP + (4 * ((gi) % GPB) + j_) * 32); } while (0)
#if ATT_KDB
    AT_KLOAD(0, kf[0]);
#endif
#pragma unroll
    for (int b = 0; b < 2; ++b) {
        if (BIAS) {
#pragma unroll
            for (int g = 0; g < 4; ++g) { const f32x4 bv = *(const LAS f32x4*)(buf + L::BIAS_OFF + (32 * b + 8 * g + 4 * hh) * 4);
                p[b][4 * g + 0] = bv[0]; p[b][4 * g + 1] = bv[1]; p[b][4 * g + 2] = bv[2]; p[b][4 * g + 3] = bv[3]; }
        } else {
#pragma unroll
            for (int r = 0; r < 16; ++r) p[b][r] = 0.f;
        }
    }
    __builtin_amdgcn_sched_barrier(0);
#pragma unroll
    for (int gi = 0; gi < NKG; ++gi) {
#if ATT_KDB
        if (gi + 1 < NKG) AT_KLOAD(gi + 1, kf[(gi + 1) & 1]);
#else
        AT_KLOAD(gi, kf[gi & 1]);
#endif
        __builtin_amdgcn_sched_barrier(0);
#pragma unroll
        for (int j = 0; j < 4; ++j) p[gi / GPB] = __builtin_amdgcn_mfma_f32_32x32x16_bf16(kf[gi & 1][j], Qf[4 * (gi % GPB) + j], p[gi / GPB], 0, 0, 0);
        __builtin_amdgcn_sched_barrier(0);
    }
#undef AT_KLOAD
    u32x4 vf[2][NDB];
    const LAS unsigned char* vbase = buf + L::KBYTES + r32 * L::VP + 8 * hh;
#define AT_VLOAD(gi, dst) do { _Pragma("unroll") for (int db_ = 0; db_ < NDB; ++db_) { \
        const LAS unsigned char* vp_ = vbase + (32 * db_) * L::VP + (gi) * 32; \
        const u32x2 lo_ = *(const LAS u32x2*)vp_, hi_ = *(const LAS u32x2*)(vp_ + 16); \
        dst[db_].x = lo_.x; dst[db_].y = lo_.y; dst[db_].z = hi_.x; dst[db_].w = hi_.y; } } while (0)
#if ATT_VDB
    AT_VLOAD(0, vf[0]);
#endif
    if (need_mask) {
        const float NEG = -__builtin_inff();
#pragma unroll
        for (int b = 0; b < 2; ++b)
#pragma unroll
            for (int r = 0; r < 16; ++r) { const int krel = 32 * b + (r & 3) + 8 * (r >> 2); if ((unsigned)(dq - krel) >= W) p[b][r] = NEG; }
    }
    if (NOMAX) {
        float rs = 0.f;
#pragma unroll
        for (int b = 0; b < 2; ++b)
#pragma unroll
            for (int r = 0; r < 16; ++r) { p[b][r] = __builtin_amdgcn_exp2f(p[b][r] + rowc); rs += p[b][r]; }
        l += rs;
    } else {
    float mx = p[0][0];
#pragma unroll
    for (int r = 1; r < 16; ++r) mx = fmaxf(mx, p[0][r]);
#pragma unroll
    for (int r = 0; r < 16; ++r) mx = fmaxf(mx, p[1][r]);
    mx = fmaxf(mx, __shfl_xor(mx, 32));
    const float mn = fmaxf(m, mx);
    const float alpha = __builtin_amdgcn_exp2f(m - mn);
    m = mn;
    float rs = 0.f;
#pragma unroll
    for (int b = 0; b < 2; ++b)
#pragma unroll
        for (int r = 0; r < 16; ++r) { p[b][r] = __builtin_amdgcn_exp2f(p[b][r] - mn); rs += p[b][r]; }
    l = l * alpha + rs;
#pragma unroll
    for (int db = 0; db < NDB; ++db) o[db] = o[db] * alpha;
    }
    __builtin_amdgcn_sched_barrier(0);
#pragma unroll
    for (int gi = 0; gi < 4; ++gi) {
        const int b = gi >> 1, sx = gi & 1;
#if ATT_VDB
        if (gi + 1 < 4) AT_VLOAD(gi + 1, vf[(gi + 1) & 1]);
#else
        AT_VLOAD(gi, vf[gi & 1]);
#endif
        u32x4 pw; pw.x = cvtpk(p[b][8 * sx + 0], p[b][8 * sx + 1]); pw.y = cvtpk(p[b][8 * sx + 2], p[b][8 * sx + 3]); pw.z = cvtpk(p[b][8 * sx + 4], p[b][8 * sx + 5]); pw.w = cvtpk(p[b][8 * sx + 6], p[b][8 * sx + 7]);
        const bf16x8 pf = __builtin_bit_cast(bf16x8, pw);
        __builtin_amdgcn_sched_barrier(0);
#pragma unroll
        for (int db = 0; db < NDB; ++db) o[db] = __builtin_amdgcn_mfma_f32_32x32x16_bf16(__builtin_bit_cast(bf16x8, vf[gi & 1][db]), pf, o[db], 0, 0, 0);
        __builtin_amdgcn_sched_barrier(0);
    }
#undef AT_VLOAD
}

template <int D, bool BIAS, bool NOMAX, bool GQA = false>
__device__ __forceinline__ void attn_unit(LAS unsigned char* lds, const bf16* Qp, int ldq, const bf16* Kp, int ldk, const bf16* Vt, const float* Fh, bf16* Op, int ldo,
                                          int q0, int t_lo, int t_hi, unsigned W, float m_init, float l_init, float cbound, int wave, int lane) {
    typedef AttnL<D> L;
    constexpr int KCH = D / 64;
    const int tid = threadIdx.x, r32 = lane & 31, hh = lane >> 5;
    const int qrow0 = GQA ? q0 : q0 + 32 * wave;
    if (GQA) { Qp += wave * D; Op += wave * D; }
    bf16x8 Qf[D / 16];
#pragma unroll
    for (int ks = 0; ks < D / 16; ++ks) Qf[ks] = *(const bf16x8*)(Qp + (size_t)(qrow0 + r32) * ldq + 16 * ks + 8 * hh);
    f32x16 o[D / 32];
#pragma unroll
    for (int db = 0; db < D / 32; ++db)
#pragma unroll
        for (int r = 0; r < 16; ++r) o[db][r] = 0.f;
    float m = m_init, l = (hh == 0) ? l_init : 0.f;
    float rowc = 0.f;
    if (NOMAX) rowc = Fh[qrow0 + r32] * LOG2E - cbound;
    u32x4 kreg[KCH], vreg[KCH]; float breg = 0.f;
#define ATT_LOAD(t) do { const int kb_ = (t) * 64; \
        _Pragma("unroll") for (int i_ = 0; i_ < KCH; ++i_) { const int c_ = tid + 512 * i_; \
            { const int key_ = c_ / (D / 8), cc_ = c_ % (D / 8); kreg[i_] = *(const u32x4*)(Kp + (size_t)(kb_ + key_) * ldk + 8 * cc_); } \
            { const int d_ = c_ >> 3, kc_ = c_ & 7; vreg[i_] = *(const u32x4*)(Vt + (size_t)d_ * M + kb_ + 8 * kc_); } } \
        if (BIAS) { if (tid < 64) breg = Fh[kb_ + tid] * (-LOG2E); } } while (0)
#define ATT_STORE(bufp) do { \
        _Pragma("unroll") for (int i_ = 0; i_ < KCH; ++i_) { const int c_ = tid + 512 * i_; \
            { const int key_ = c_ / (D / 8), cc_ = c_ % (D / 8); *(LAS u32x4*)((bufp) + key_ * L::KP + cc_ * 16) = kreg[i_]; } \
            { const int d_ = c_ >> 3, kc_ = c_ & 7; *(LAS u32x4*)((bufp) + L::KBYTES + d_ * L::VP + kc_ * 16) = vreg[i_]; } } \
        if (BIAS) { if (tid < 64) *(LAS float*)((bufp) + L::BIAS_OFF + tid * 4) = breg; } } while (0)
    ATT_LOAD(t_lo);
    ATT_STORE(lds);
    __syncthreads();
    for (int t = t_lo; t < t_hi; ++t) {
        LAS unsigned char* cur = lds + ((t - t_lo) & 1) * L::BUF;
        LAS unsigned char* nxt = lds + (((t - t_lo) & 1) ^ 1) * L::BUF;
        if (t + 1 < t_hi) ATT_LOAD(t + 1);
        const int kb = t * 64;
        const long long lo_need = (long long)qrow0 - (long long)(W - 1u);
        const bool active = (kb <= qrow0 + 31) && ((long long)kb + 63 >= lo_need);
        if (active) {
            const bool full = (kb + 63 <= qrow0) && ((long long)kb >= (long long)qrow0 + 31 - (long long)(W - 1u));
            attn_tile<D, BIAS, NOMAX>(cur, Qf, o, m, l, rowc, (qrow0 + r32) - kb - 4 * hh, W, !full, lane);
        }
        if (t + 1 < t_hi) ATT_STORE(nxt);
        __syncthreads();
    }
#undef ATT_LOAD
#undef ATT_STORE
    const float lt = l + __shfl_xor(l, 32);
    const float inv = 1.0f / lt;
    bf16* orow = Op + (size_t)(qrow0 + r32) * ldo;
#pragma unroll
    for (int db = 0; db < D / 32; ++db)
#pragma unroll
        for (int g = 0; g < 4; ++g) {
            u32x2 w; w.x = cvtpk(o[db][4 * g + 0] * inv, o[db][4 * g + 1] * inv); w.y = cvtpk(o[db][4 * g + 2] * inv, o[db][4 * g + 3] * inv);
            *(u32x2*)(orow + 32 * db + 8 * g + 4 * hh) = w;
        }
}

__device__ __forceinline__ void fox_norm_phase(const Params& P, int wave, int lane) {
    const bf16* Q = (const bf16*)(P.ws + WS_Q); const bf16* K = (const bf16*)(P.ws + WS_K);
    unsigned* ctl = (unsigned*)(P.ws + WS_MOD);
    const int gw = blockIdx.x * NWAVES + wave, NGW = gridDim.x * NWAVES;
    for (int it = gw; it < 2 * 8 * 256; it += NGW) {
        const int isk = it & 1, head = (it >> 1) & 7, tile = it >> 4;
        const bf16* src = (isk ? K : Q) + (size_t)tile * 64 * FW + head * 128;
        float mx = 0.f;
        u32x4 wv[16];
#pragma unroll
        for (int i = 0; i < 16; ++i) wv[i] = *(const u32x4*)(src + (size_t)(4 * i + (lane >> 4)) * FW + 8 * (lane & 15));
#pragma unroll
        for (int i = 0; i < 16; ++i) {
            const u32x4 w = wv[i];
            float a = bflo(w.x) * bflo(w.x) + bfhi(w.x) * bfhi(w.x); a += bflo(w.y) * bflo(w.y) + bfhi(w.y) * bfhi(w.y);
            a += bflo(w.z) * bflo(w.z) + bfhi(w.z) * bfhi(w.z); a += bflo(w.w) * bflo(w.w) + bfhi(w.w) * bfhi(w.w);
            a += __shfl_xor(a, 1); a += __shfl_xor(a, 2); a += __shfl_xor(a, 4); a += __shfl_xor(a, 8);
            mx = fmaxf(mx, a);
        }
        mx = fmaxf(mx, __shfl_xor(mx, 16)); mx = fmaxf(mx, __shfl_xor(mx, 32));
        if (lane == 0) atomicMax(ctl + (isk ? CW_KMAX2 + head : CW_QN2 + head * 64 + (tile >> 2)), __float_as_uint(mx));
    }
}
__device__ __forceinline__ void fox_phase(const Params& P, LAS unsigned char* lds, int wave, int lane) {
    const bf16* Q = (const bf16*)(P.ws + WS_Q); const bf16* K = (const bf16*)(P.ws + WS_K); const bf16* VT = (const bf16*)(P.ws + WS_VT);
    const float* F = (const float*)(P.ws + WS_F); bf16* MIX = (bf16*)(P.ws + WS_MIX);
    const unsigned* ctl = (const unsigned*)(P.ws + WS_MOD);
    for (int it = (int)VCU(lds); it < 256; it += gridDim.x) {
        const int head = it & 7, pi = it >> 3;
#pragma unroll 1
        for (int half = 0; half < 2; ++half) {
            const int qb = half == 0 ? 63 - pi : pi;
            const float* Fh = F + (size_t)head * M;
            const float kn = sqrtf(__uint_as_float(ctl[CW_KMAX2 + head])), qn = sqrtf(__uint_as_float(ctl[CW_QN2 + head * 64 + qb]));
            const float bound = 2.0f * qn * kn * 1.01f + 2.0f;
            const int j = threadIdx.x;
            const bool skippable = (j < 4 * qb) && (bound + (Fh[qb * 256] - Fh[j < 256 ? 64 * j + 63 : 63]) * LOG2E < -152.0f);
            const int t_lo = __syncthreads_count(skippable ? 1 : 0);
            attn_unit<128, true, true>(lds, Q + head * 128, FW, K + head * 128, FW, VT + (size_t)head * 128 * M, Fh, MIX + head * 128, DM,
                                       qb * 256, t_lo, 4 * qb + 4, 0x7fffffffu, -1e30f, 0.f, fminf(0.5f * bound, 55.0f), wave, lane);
        }
    }
}

__device__ __forceinline__ void swa_phase(const Params& P, LAS unsigned char* lds, int wave, int lane) {
    const bf16* Q = (const bf16*)(P.ws + WS_Q2); const bf16* K = (const bf16*)(P.ws + WS_K2); const bf16* VT = (const bf16*)(P.ws + WS_VT2); bf16* O = (bf16*)(P.ws + WS_MIX);
    for (int it = (int)VCU(lds); it < 2048; it += gridDim.x) {
        const int kv = (it & 7) >> 1, rb = ((it & 1) << 8) | (it >> 3);
        const int q0 = rb * 32;
        const float sinkl = P.sinks[kv * 8 + wave] * LOG2E;
        const int t_lo = (q0 - 127) < 0 ? 0 : ((q0 - 127) >> 6), t_hi = (q0 >> 6) + 1;
        attn_unit<64, false, false, true>(lds, Q + kv * 512, DM, K + kv * 64, KVW, VT + (size_t)kv * 64 * M, nullptr, O + kv * 512, DM, q0, t_lo, t_hi, 128u, sinkl, 1.0f, 0.f, wave, lane);
    }
}

constexpr int SSM_SUB = 256, SSM_NSUB = M / SSM_SUB  , SSM_STEPS = SSM_SUB / 16;
struct SsmC2 { f32x2 lb[2]; f32x2 lbR[2]; bf16x8 Bh[4], Bl[4]; };
__device__ __forceinline__ void ssm_consts2(const Params& P, int g, int lane, SsmC2& C) {
    const int p5 = lane & 31, hh = lane >> 5;
    const double dtf = exp((double)P.log_dt[g]);
#pragma unroll
    for (int par = 0; par < 2; ++par) {
        const int st = 2 * p5 + par;
        const double lr = (double)P.lam_re[g * 64 + st], li = (double)P.lam_im[g * 64 + st];
        const double mag = exp(lr * dtf);
        double s, c; sincos_d(li * dtf, s, c);
        const double lbr = mag * c, lbi = mag * s;
        const double den = lr * lr + li * li, nr = lbr - 1.0;
        const double qr = (nr * lr + lbi * li) / den, qi = (lbi * lr - nr * li) / den;
        C.lb[par] = (f32x2){(float)lbr, (float)lbi};
        const double magR = exp(lr * dtf * SSM_SUB);
        double sR, cR; sincos_d(li * dtf * SSM_SUB, sR, cR);
        C.lbR[par] = (f32x2){(float)(magR * cR), (float)(magR * sR)};
        const f32x4* br = (const f32x4*)(P.b_re + (size_t)(g * 64 + st) * 16 + 8 * hh); const f32x4* bi = (const f32x4*)(P.b_im + (size_t)(g * 64 + st) * 16 + 8 * hh);
        float vre[8], vim[8];
#pragma unroll
        for (int j = 0; j < 2; ++j) { const f32x4 r = br[j], i = bi[j];
#pragma unroll
            for (int e = 0; e < 4; ++e) { const double rr = (double)r[e], ii = (double)i[e]; vre[4 * j + e] = (float)(qr * rr - qi * ii); vim[4 * j + e] = (float)(qr * ii + qi * rr); } }
        u32x4 hr, lr4, hi4, li4;
#pragma unroll
        for (int e = 0; e < 4; ++e) {
            const unsigned wr = cvtpk(vre[2 * e], vre[2 * e + 1]); hr[e] = wr; lr4[e] = cvtpk(vre[2 * e] - bflo(wr), vre[2 * e + 1] - bfhi(wr));
            const unsigned wi = cvtpk(vim[2 * e], vim[2 * e + 1]); hi4[e] = wi; li4[e] = cvtpk(vim[2 * e] - bflo(wi), vim[2 * e + 1] - bfhi(wi));
        }
        C.Bh[par] = __builtin_bit_cast(bf16x8, hr); C.Bl[par] = __builtin_bit_cast(bf16x8, lr4);
        C.Bh[2 + par] = __builtin_bit_cast(bf16x8, hi4); C.Bl[2 + par] = __builtin_bit_cast(bf16x8, li4);
    }
}
__device__ __forceinline__ void ssm_bu(const SsmC2& C, const bf16x8 ua, f32x16 (&acc)[4]) {
#pragma unroll
    for (int b = 0; b < 4; ++b) {
#pragma unroll
        for (int r = 0; r < 16; ++r) acc[b][r] = 0.f;
        acc[b] = __builtin_amdgcn_mfma_f32_32x32x16_bf16(ua, C.Bh[b], acc[b], 0, 0, 0);
        acc[b] = __builtin_amdgcn_mfma_f32_32x32x16_bf16(ua, C.Bl[b], acc[b], 0, 0, 0);
    }
}
__device__ __forceinline__ void ssm_upd(const f32x2 lb, f32x2& x, float bre, float bim) {
    const f32x2 nx = {__builtin_fmaf(lb.x, x.x, __builtin_fmaf(-lb.y, x.y, bre)), __builtin_fmaf(lb.x, x.y, __builtin_fmaf(lb.y, x.x, bim))};
    x = nx;
}
__device__ __forceinline__ void ssm_pass1(const Params& P, LAS unsigned char* lds, int wave, int lane) {
    const bf16* U = (const bf16*)(P.ws + WS_U); f32x4* E = (f32x4*)(P.ws + WS_E);
    const int gw = __builtin_amdgcn_readfirstlane(blockIdx.x * NWAVES + wave), NGW = gridDim.x * NWAVES;
    const int p5 = lane & 31, hh = lane >> 5;
    const int asr = (p5 >> 2) & 1, ajj = (p5 & 3) + 4 * (p5 >> 3);
    for (int it = gw; it < 64 * (SSM_NSUB / 2); it += NGW) {
        const int g = it & 63, run = it >> 6;
        const bf16* up = U + ((size_t)(run * 2 + asr) * SSM_SUB + 8 * ajj) * FW + g * 16 + 8 * hh;
        bf16x8 ua[8];
#pragma unroll
        for (int ks = 0; ks < 8; ++ks) ua[ks] = *(const bf16x8*)(up + (size_t)ks * FW);
        const double dtf = exp((double)P.log_dt[g]);
        f32x2 xe[2] = {{0.f, 0.f}, {0.f, 0.f}};
#pragma unroll
        for (int par = 0; par < 2; ++par) {
            const int st = 2 * p5 + par;
            const double lr = (double)P.lam_re[g * 64 + st], li = (double)P.lam_im[g * 64 + st];
            const double mag = exp(lr * dtf);
            double s, c; sincos_d(li * dtf, s, c);
            const double lbr = mag * c, lbi = mag * s;
            const double den = lr * lr + li * li, nr = lbr - 1.0;
            const double qr = (nr * lr + lbi * li) / den, qi = (lbi * lr - nr * li) / den;
            const f32x4* br = (const f32x4*)(P.b_re + (size_t)(g * 64 + st) * 16 + 8 * hh); const f32x4* bi = (const f32x4*)(P.b_im + (size_t)(g * 64 + st) * 16 + 8 * hh);
            float vre[8], vim[8];
#pragma unroll
            for (int j = 0; j < 2; ++j) { const f32x4 r = br[j], i = bi[j];
#pragma unroll
                for (int e = 0; e < 4; ++e) { const double rr = (double)r[e], ii = (double)i[e]; vre[4 * j + e] = (float)(qr * rr - qi * ii); vim[4 * j + e] = (float)(qr * ii + qi * rr); } }
            const float lx = (float)lbr, ly = (float)lbi;
            float wx = 1.f, wy = 0.f;
            bf16x8 Wre[8], Wim[8];
#pragma unroll
            for (int ks = 7; ks >= 0; --ks) {
                u32x4 fr4, fi4;
#pragma unroll
                for (int e = 0; e < 4; ++e) {
                    fr4[e] = cvtpk(wx * vre[2 * e] - wy * vim[2 * e], wx * vre[2 * e + 1] - wy * vim[2 * e + 1]);
                    fi4[e] = cvtpk(wx * vim[2 * e] + wy * vre[2 * e], wx * vim[2 * e + 1] + wy * vre[2 * e + 1]);
                }
                Wre[ks] = __builtin_bit_cast(bf16x8, fr4); Wim[ks] = __builtin_bit_cast(bf16x8, fi4);
                const float nx = wx * lx - wy * ly, ny = wx * ly + wy * lx; wx = nx; wy = ny;
            }
            const f32x2 l8 = {wx, wy};
#pragma unroll
            for (int c2 = 0; c2 < 2; ++c2) {
                if (!(par == 0 && c2 == 0)) {
#pragma unroll
                    for (int ks = 0; ks < 8; ++ks) ua[ks] = *(const bf16x8*)(up + (size_t)(c2 * 128 + ks) * FW);
                }
                f32x16 are, aim;
#pragma unroll
                for (int r = 0; r < 16; ++r) { are[r] = 0.f; aim[r] = 0.f; }
#pragma unroll
                for (int ks = 0; ks < 8; ++ks) { are = __builtin_amdgcn_mfma_f32_32x32x16_bf16(ua[ks], Wre[ks], are, 0, 0, 0); aim = __builtin_amdgcn_mfma_f32_32x32x16_bf16(ua[ks], Wim[ks], aim, 0, 0, 0); }
#pragma unroll
                for (int r = 0; r < 16; ++r) ssm_upd(l8, xe[par], are[r], aim[r]);
            }
        }
        E[((size_t)(run * 2 + hh) * 64 + g) * 32 + p5] = (f32x4){xe[0].x, xe[0].y, xe[1].x, xe[1].y};
    }
}
__device__ __forceinline__ float sigmoid_f(float v) { return __builtin_amdgcn_rcpf(1.0f + __builtin_amdgcn_exp2f(-1.4426950408889634f * v)); }
__device__ __forceinline__ float gelu_tanh_f(float y) { const float z = 0.7978845608028654f * (y + 0.044715f * y * y * y); return y * sigmoid_f(2.0f * z); }
__device__ __forceinline__ void ssm_pass2(const Params& P, LAS unsigned char* lds, int wave, int lane) {
    const bf16* U = (const bf16*)(P.ws + WS_U); const f32x4* E = (const f32x4*)(P.ws + WS_E); bf16* S = (bf16*)(P.ws + WS_S);
    LAS unsigned char* XL = lds + wave * 8192;
    const int gw = __builtin_amdgcn_readfirstlane(blockIdx.x * NWAVES + wave), NGW = gridDim.x * NWAVES;
    const int p5 = lane & 31, hh = lane >> 5;
    const int ahh = (p5 >> 2) & 1, ar = (p5 & 3) + 4 * (p5 >> 3);
    const int h = lane & 15, tq = lane >> 4;
    for (int it = gw; it < 64 * (SSM_NSUB / 2); it += NGW) {
        const int g = it & 63, run = it >> 6;
        SsmC2 C; ssm_consts2(P, g, lane, C);
        const bf16* up = U + ((size_t)(run * 2 + ahh) * SSM_SUB + ar) * FW + g * 16 + 8 * hh;
        bf16x8 u0 = *(const bf16x8*)up, u1 = *(const bf16x8*)(up + (size_t)16 * FW), u2 = *(const bf16x8*)(up + (size_t)32 * FW), u3 = *(const bf16x8*)(up + (size_t)48 * FW);
        bf16x8 Cf[4];
#pragma unroll
        for (int ks = 0; ks < 4; ++ks) {
            const f32x4 cr = *(const f32x4*)(P.c_re + (size_t)(g * 16 + h) * 64 + 16 * ks + 4 * tq), ci = *(const f32x4*)(P.c_im + (size_t)(g * 16 + h) * 64 + 16 * ks + 4 * tq);
            u32x4 w; w.x = cvtpk(cr[0], -ci[0]); w.y = cvtpk(cr[1], -ci[1]); w.z = cvtpk(cr[2], -ci[2]); w.w = cvtpk(cr[3], -ci[3]);
            Cf[ks] = __builtin_bit_cast(bf16x8, w);
        }
        const float dsk = P.ssm_d[g * 16 + h];
        f32x2 x0 = {0.f, 0.f}, x1 = {0.f, 0.f};
        const int sr = 2 * run + hh;
#pragma unroll 8
        for (int rr = 0; rr < 2 * run + 1; ++rr) {
            const f32x4 e = E[((size_t)rr * 64 + g) * 32 + p5];
            if (rr < sr) { ssm_upd(C.lbR[0], x0, e[0], e[1]); ssm_upd(C.lbR[1], x1, e[2], e[3]); }
        }
        LAS unsigned char* wbase = XL + hh * 16 * 256 + (p5 & 1) * 8;
#pragma unroll 1
        for (int step = 0; step < SSM_STEPS; ++step) {
            const bf16x8 ua = u0; u0 = u1; u1 = u2; u2 = u3;
            if (step + 4 < SSM_STEPS) u3 = *(const bf16x8*)(up + (size_t)(step + 4) * 16 * FW);
            unsigned short uvr[2][4];
#pragma unroll
            for (int rb = 0; rb < 2; ++rb)
#pragma unroll
                for (int q = 0; q < 4; ++q) uvr[rb][q] = U[((size_t)(run * 2 + rb) * SSM_SUB + step * 16 + 4 * tq + q) * FW + g * 16 + h];
            f32x16 acc[4]; ssm_bu(C, ua, acc);
#pragma unroll
            for (int r = 0; r < 16; ++r) {
                ssm_upd(C.lb[0], x0, acc[0][r], acc[2][r]); ssm_upd(C.lb[1], x1, acc[1][r], acc[3][r]);
                u32x2 w; w.x = cvtpk(x0.x, x0.y); w.y = cvtpk(x1.x, x1.y);
                *(LAS u32x2*)(wbase + r * 256 + (((p5 >> 1) ^ r) << 4)) = w;
            }
            asm volatile("s_waitcnt lgkmcnt(0)" ::: "memory");
#pragma unroll
            for (int rb = 0; rb < 2; ++rb) {
                f32x4 ya = {0.f, 0.f, 0.f, 0.f};
#pragma unroll
                for (int ks = 0; ks < 4; ++ks) {
                    const bf16x8 af = *(const LAS bf16x8*)(XL + (16 * rb + h) * 256 + (((4 * ks + tq) ^ h) << 4));
                    ya = __builtin_amdgcn_mfma_f32_16x16x32_bf16(af, Cf[ks], ya, 0, 0, 0);
                }
#pragma unroll
                for (int q = 0; q < 4; ++q) {
                    const size_t tok = (size_t)(run * 2 + rb) * SSM_SUB + step * 16 + 4 * tq + q;
                    const float uv = __builtin_bit_cast(float, (unsigned)uvr[rb][q] << 16);
                    S[tok * FW + g * 16 + h] = (bf16)f2bf(gelu_tanh_f(ya[q] + dsk * uv));
                }
            }
            asm volatile("s_waitcnt lgkmcnt(0)" ::: "memory");
        }
    }
}
#define XB_TMO      128
#define XB_XCNT(j)  (256  + 64 * (j))
#define XB_XSUB(j)  (1280 + 64 * (j))
#define XB_XGEN(j)  (2304 + 64 * (j))
#define XB_TOP      3328
#define XB_TOPGEN   3392
#define XCD_BAR_WORDS 3456
#define XB_SPIN_CAP (1u << 23)

__device__ __forceinline__ unsigned xb_ld(unsigned* p)              { return __hip_atomic_load(p, __ATOMIC_RELAXED, __HIP_MEMORY_SCOPE_AGENT); }
__device__ __forceinline__ unsigned xb_add(unsigned* p, unsigned v) { return __hip_atomic_fetch_add(p, v, __ATOMIC_RELAXED, __HIP_MEMORY_SCOPE_AGENT); }
__device__ __forceinline__ unsigned xb_xcc_id() { return (unsigned)__builtin_amdgcn_s_getreg((3 << 11) | 20) & 0xFu; }
#define XB_SPIN(cond, bar) do { unsigned _sp = 0; while (cond) { __builtin_amdgcn_s_sleep(1); \
    if ((++_sp & 255u) == 0u) { if (xb_ld(&(bar)[XB_TMO])) break; if (_sp > XB_SPIN_CAP) { atomicAdd(&(bar)[XB_TMO], 1u); break; } } } } while (0)

struct XcdBarrier {
    unsigned* bar; unsigned x;
    volatile LAS unsigned* st;
};

__device__ __forceinline__ XcdBarrier xcd_barrier_post(unsigned* bar, volatile LAS unsigned* st) {
    XcdBarrier b; b.bar = bar; b.x = xb_xcc_id(); b.st = st;
    if (threadIdx.x == 0) st[3] = xb_add(&bar[XB_XCNT(b.x)], 1u);
    return b;
}
__device__ __forceinline__ void xcd_barrier_complete(unsigned* bar, unsigned x, unsigned& nloc, unsigned& nx) {
    const unsigned G = gridDim.x * gridDim.y * gridDim.z;
    unsigned sum, cnt, mine, sp = 0u;
    for (;;) {
        sum = 0u; cnt = 0u; mine = 0u;
#pragma unroll
        for (unsigned j = 0; j < 16; ++j) { const unsigned c = xb_ld(&bar[XB_XCNT(j)]); sum += c; cnt += (c > 0u) ? 1u : 0u; mine = (j == x) ? c : mine; }
        if (sum == G) break;
        __builtin_amdgcn_s_sleep(1);
        if ((++sp & 255u) == 0u) { if (xb_ld(&bar[XB_TMO])) break; if (sp > XB_SPIN_CAP) { atomicAdd(&bar[XB_TMO], 1u); break; } }
    }
    nloc = mine > 0u ? mine : 1u; nx = cnt > 0u ? cnt : 1u;
}

__device__ __forceinline__ void xcd_barrier(const XcdBarrier& b) {
    asm volatile("s_waitcnt vmcnt(0)" ::: "memory");
    __syncthreads();
    if (threadIdx.x == 0) {
        unsigned* bar = b.bar;
        __builtin_amdgcn_s_waitcnt(0);
        unsigned nloc = b.st[0], nx = b.st[1];
        if (nloc == 0u) { xcd_barrier_complete(bar, b.x, nloc, nx); b.st[0] = nloc; b.st[1] = nx; }
        const unsigned old = xb_add(&bar[XB_XSUB(b.x)], 1u);
        const unsigned gen = old / nloc;
        if (old + 1u == (gen + 1u) * nloc) {
            __builtin_amdgcn_fence(__ATOMIC_RELEASE, "agent");
            asm volatile("s_waitcnt vmcnt(0)" ::: "memory");
            const unsigned og = xb_add(&bar[XB_TOP], 1u);
            const unsigned tg = og / nx;
            if (og + 1u == (tg + 1u) * nx) xb_add(&bar[XB_TOPGEN], 1u);
            else XB_SPIN(xb_ld(&bar[XB_TOPGEN]) == tg, bar);
            __builtin_amdgcn_fence(__ATOMIC_ACQUIRE, "agent");
            xb_add(&bar[XB_XGEN(b.x)], 1u);
            asm volatile("s_waitcnt vmcnt(0)" ::: "memory");
        } else {
            XB_SPIN(xb_ld(&bar[XB_XGEN(b.x)]) == gen, bar);
            __builtin_amdgcn_fence(__ATOMIC_ACQUIRE, "agent");
            asm volatile("s_waitcnt vmcnt(0)" ::: "memory");
        }
    }
    __syncthreads();
}

__device__ __forceinline__ int opaque_lane(int lane) { asm volatile("" : "+v"(lane)); return lane; }
constexpr int CW_BAR = 28672;
#ifdef PROBE_SYNC2
#define GSYNC() do { xcd_barrier(bar); xcd_barrier(bar); } while (0)
#else
#define GSYNC() xcd_barrier(bar)
#endif
#ifndef PG8_SP2
#define PG8_SP2 true
#endif
#ifndef PG8_ALIGN
#define PG8_ALIGN true
#endif
template <class Epi>
__device__ __forceinline__ void run_gemm(LAS unsigned char* lds, const bf16* A, const bf16* Bt, int m, int n, int k, const Epi& E, int cshift) {
    pg8::Gemm g{A, Bt, m, n, k}; pg8::StaticOrder S; S.init(m, n, (int)gridDim.x, (int)((VCU(lds) + cshift) % gridDim.x));
    pg8::gemm_phase<Epi, pg8::StaticOrder, PG8_ALIGN, PG8_SP2>(lds, g, S, E);
}

template <class Epi>
__device__ __forceinline__ void run_gemm_panel(LAS unsigned char* lds, const bf16* A, const bf16* Bt, int k, const Epi& E) {
    pg8::Gemm g{A, Bt, M, DM, k}; pg8::PanelOrder S; S.init((int)VCU(lds));
    pg8::gemm_phase<Epi, pg8::PanelOrder, PG8_ALIGN, PG8_SP2>(lds, g, S, E);
}
__device__ __forceinline__ void ffn_part(const Params& P, const int layer, LAS unsigned char* lds, const XcdBarrier& bar, int wave, int lane) {
    unsigned char* ws = P.ws;
    const float* mod = (const float*)(ws + WS_MOD);
    const float* md = mod + layer * 12288;
    bf16* H = (bf16*)(ws + WS_H); bf16* MID = (bf16*)(ws + WS_MID); float* XA = P.out;
    float* STAT = (float*)(ws + WS_STAT); unsigned* PCNT = (unsigned*)(ws + WS_PCNT);
    const float* st_mix = STAT + (size_t)(2 * layer) * 2 * M; float* st_ffn = STAT + (size_t)(2 * layer + 1) * 2 * M;
    {
        pg8::EpiSwiglu E{MID, DFF};
        run_gemm(lds, H, (const bf16*)(ws + (layer == 0 ? WS_WGU0 : WS_WGU1)), M, 2 * DFF, DM, E, 0);
#ifdef PROBE_GU2
        if (layer == 0) run_gemm(lds, H, (const bf16*)(ws + (layer == 0 ? WS_WGU0 : WS_WGU1)), M, 2 * DFF, DM, E, 0);
#endif
    }
    GSYNC();
    if (layer == 0) {
        pg8::EpiResidLNF<true, false> E{XA, XA, md + 5 * DM, ALPHA, DM, st_mix, P.ln_mix_g, P.ln_mix_b, st_ffn, PCNT + 1 * 4096, P.ln_ffn_g, P.ln_ffn_b, mod + 12288, mod + 12288 + DM, H, nullptr};
        run_gemm_panel(lds, MID, (const bf16*)(ws + WS_WD0), DFF, E);
    } else {
        pg8::EpiResidLNF<true, true> E{XA, XA, md + 5 * DM, ALPHA, DM, st_mix, P.ln_mix_g + DM, P.ln_mix_b + DM, st_ffn, PCNT + 3 * 4096, P.ln_ffn_g + DM, P.ln_ffn_b + DM, nullptr, nullptr, nullptr, XA};
        run_gemm_panel(lds, MID, (const bf16*)(ws + WS_WD1), DFF, E);
    }
}

__global__ void __launch_bounds__(NTHR, 2) mega_fwd(Params P) {
    extern __shared__ __attribute__((aligned(16))) unsigned char lds_raw[];
    cg::grid_group grid = cg::this_grid();
    LAS unsigned char* lds = (LAS unsigned char*)lds_raw;
    const int tid = threadIdx.x, lane = tid & 63, wave = __builtin_amdgcn_readfirstlane(tid >> 6);
    unsigned char* ws = P.ws;
    const float* mod = (const float*)(ws + WS_MOD);
    bf16* H = (bf16*)(ws + WS_H); bf16* MIX = (bf16*)(ws + WS_MIX); bf16* MID = (bf16*)(ws + WS_MID);
    float* XA = P.out;

    if (tid < 4) ((LAS unsigned*)(lds + LDS_BARST))[tid] = 0u;
    __syncthreads();
    const XcdBarrier bar = xcd_barrier_post((unsigned*)(ws + WS_MOD) + CW_BAR, (volatile LAS unsigned*)(lds + LDS_BARST));
#ifndef SK_P0
    p0_prologue(P, lds, wave, opaque_lane(lane));
#endif
    GSYNC();
    if (P.out == nullptr) grid.sync();
    if (tid == 0) {
        volatile LAS unsigned* st = (volatile LAS unsigned*)(lds + LDS_BARST);
        const unsigned rank = st[3], xcc = bar.x; unsigned v = 0;
#pragma unroll
        for (unsigned j = 0; j < 16; ++j) { const unsigned c = xb_ld(&bar.bar[XB_XCNT(j)]); v += (c < rank ? c : rank) + ((j < xcc && c > rank) ? 1u : 0u); }
#ifdef NO_VCU
        v = blockIdx.x;
#endif
        st[2] = v;
    }
    __syncthreads();
#ifndef SK_HPREP
    hprep_phase(P, lds, wave, opaque_lane(lane));
#if defined(PROBE_MISC2) || defined(PROBE_HPREP2)
    hprep_phase(P, lds, wave, opaque_lane(lane));
#endif
#endif
    GSYNC();

#ifndef SK_CUMSUM
    cumsum_phase(P, lds, wave, opaque_lane(lane));
#endif
    {
        pg8::EpiBf16<0> E{(bf16*)(ws + WS_Q), FW, nullptr, FW, (size_t)M * FW, 0.08838834764831845f * LOG2E};
        run_gemm(lds, H, (const bf16*)(ws + WS_W1T), M, 3 * FW, DM, E, 0);
    }
    {
        pg8::EpiBf16<0> E{(bf16*)(ws + WS_VT), M, nullptr, 0, 0, 1.0f};
        run_gemm(lds, (const bf16*)(ws + WS_WVT), H, FW, M, DM, E, 0);
    }
    GSYNC();
    fox_norm_phase(P, wave, opaque_lane(lane));
#ifndef SK_SSM1
    ssm_pass1(P, lds, wave, opaque_lane(lane));
#endif
#if defined(PROBE_MISC2) || defined(PROBE_P3A2)
    fox_norm_phase(P, wave, opaque_lane(lane)); ssm_pass1(P, lds, wave, opaque_lane(lane));
#endif
#ifdef PROBE_SSM1ONLY
    ssm_pass1(P, lds, wave, opaque_lane(lane));
#endif
#ifdef PROBE_CONSTS
    ssm_probe_consts(P, wave, opaque_lane(lane));
#endif
#ifdef PROBE_NORM2
    fox_norm_phase(P, wave, opaque_lane(lane));
#endif
    GSYNC();
#ifndef SK_FOX
    fox_phase(P, lds, wave, opaque_lane(lane));
#ifdef PROBE_FOX2
    __syncthreads(); fox_phase(P, lds, wave, opaque_lane(lane));
#endif
#endif
    __syncthreads();
#ifndef SK_SSM2
    ssm_pass2(P, lds, wave, opaque_lane(lane));
#ifdef PROBE_SSM2
    ssm_pass1(P, lds, wave, opaque_lane(lane)); ssm_pass2(P, lds, wave, opaque_lane(lane));
#endif
#endif
    GSYNC();
    {
        pg8::EpiGlu E{(const bf16*)(ws + WS_S), FW, P.b_glu, MIX, DM, FW};
        run_gemm(lds, (const bf16*)(ws + WS_S), (const bf16*)(ws + WS_WGLU), M, FW, FW, E, 0);
    }
    GSYNC();
    {
        pg8::EpiResidLNF<false, false> E{P.x, XA, mod + 2 * DM, ALPHA, DM, nullptr, nullptr, nullptr, (float*)(ws + WS_STAT), (unsigned*)(ws + WS_PCNT), P.ln_mix_g, P.ln_mix_b, mod + 3 * DM, mod + 4 * DM, H, nullptr};
        run_gemm_panel(lds, MIX, (const bf16*)(ws + WS_WOUT), DM, E);
    }
    GSYNC();
    ffn_part(P, 0, lds, bar, wave, lane);
    GSYNC();
    {
        const float* md = mod + 12288;
        {
            pg8::EpiQKRot E{(bf16*)(ws + WS_Q2), DM, 8, 0.125f * LOG2E, (bf16*)(ws + WS_K2), KVW, (const float*)(ws + WS_COS), (const float*)(ws + WS_SIN)};
            run_gemm(lds, H, (const bf16*)(ws + WS_WC1T), M, DM + KVW, DM, E, 0);
        }
        {
            pg8::EpiBf16<0> E{(bf16*)(ws + WS_VT2), M, nullptr, 0, 0, 1.0f};
            run_gemm(lds, (const bf16*)(ws + WS_WCVT), H, KVW, M, DM, E, 192);
        }
        { const unsigned v = VCU(lds); if (v >= 128u) convert_items(P, (LAS float*)(lds + wave * 16384), P.n_items_p0, P.n_items, (int)(v - 128u) * NWAVES + wave, 128 * NWAVES, opaque_lane(lane)); }
        GSYNC();
#ifndef SK_SWA
        swa_phase(P, lds, wave, opaque_lane(lane));
#if defined(PROBE_SWA2) || defined(PROBE_MISC2)
        swa_phase(P, lds, wave, opaque_lane(lane));
#endif
#endif
        GSYNC();
        {
            pg8::EpiResidLNF<true, false> E{XA, XA, md + 2 * DM, ALPHA, DM, (const float*)(ws + WS_STAT) + 1 * 2 * M, P.ln_ffn_g, P.ln_ffn_b, (float*)(ws + WS_STAT) + 2 * 2 * M,
                                           (unsigned*)(ws + WS_PCNT) + 2 * 4096, P.ln_mix_g + DM, P.ln_mix_b + DM, md + 3 * DM, md + 4 * DM, H, nullptr};
            run_gemm_panel(lds, MIX, (const bf16*)(ws + WS_WOC), DM, E);
        }
        GSYNC();
    }
    ffn_part(P, 1, lds, bar, wave, lane);
}

static void add_td(Params& p, int& n, int& items, const float* src, bf16* dst, int ld, int K, int ncols, int mode, int row_off) {
    TDesc& d = p.td[n++]; d.src = src; d.dst = dst; d.ld = ld; d.K = K; d.ncols = ncols; d.mode = mode; d.row_off = row_off; d.first = items;
    items += (K / 64) * (ncols / 32);
}
extern "C" void kernel_launch(void* const* d_in, const int* in_sizes, int n_in, void* d_out, int out_size, void* d_ws, size_t ws_size, hipStream_t stream) {
    static int grid = 0;
    if (grid == 0) {
        if (n_in != 28 || in_sizes[0] != M * DM || out_size != M * DM || ws_size < WS_END) {
            fprintf(stderr, "kernel_launch: unexpected problem (n_in %d, in0 %d, out %d, ws %zu); nothing launched\n", n_in, n_in > 0 ? in_sizes[0] : -1, out_size, ws_size); grid = -1; return; }
        int dev = 0, cus = 0, per_cu = 0;
        (void)hipGetDevice(&dev);
        (void)hipDeviceGetAttribute(&cus, hipDeviceAttributeMultiprocessorCount, dev);
        if (hipFuncSetAttribute((const void*)mega_fwd, hipFuncAttributeMaxDynamicSharedMemorySize, LDS_BYTES) != hipSuccess) { fprintf(stderr, "kernel_launch: hipFuncSetAttribute failed\n"); grid = -1; return; }
        if (hipOccupancyMaxActiveBlocksPerMultiprocessor(&per_cu, (const void*)mega_fwd, NTHR, LDS_BYTES) != hipSuccess || per_cu < 1) { fprintf(stderr, "kernel_launch: occupancy query gives %d\n", per_cu); per_cu = 1; }
        (void)hipGetLastError();
        grid = cus * 1;
        if (grid != 256) { fprintf(stderr, "kernel_launch: this kernel's fused LayerNorm epilogues need a 256-workgroup grid (256 CUs); got %d\n", grid); grid = -1; return; }
        fprintf(stderr, "kernel_launch: %d CUs, occupancy %d per CU, grid %d\n", cus, per_cu, grid);
    }
    if (grid < 0) return;
    unsigned char* ws = (unsigned char*)d_ws;
    (void)hipMemsetAsync(ws + WS_MOD, 0, CTL_ZERO_BYTES, stream);
    Params p; memset(&p, 0, sizeof(p));
    const float* const* in = (const float* const*)d_in;
    p.x = in[0]; p.c = in[1]; p.pos = (const int*)d_in[2];
    p.w_in_ab = in[3]; p.b_forget = in[4]; p.lam_re = in[5]; p.lam_im = in[6]; p.log_dt = in[7]; p.b_re = in[8]; p.b_im = in[9]; p.c_re = in[10]; p.c_im = in[11]; p.ssm_d = in[12];
    p.w_glu = in[13]; p.b_glu = in[14]; p.w_out_ab = in[15]; p.w_in_c = in[16]; p.sinks = in[17]; p.w_out_c = in[18]; p.w_ada = in[19]; p.b_ada = in[20];
    p.ln_mix_g = in[21]; p.ln_mix_b = in[22]; p.ln_ffn_g = in[23]; p.ln_ffn_b = in[24]; p.w_gate = in[25]; p.w_up = in[26]; p.w_down = in[27];
    p.out = (float*)d_out; p.ws = ws;
    int n = 0, items = 0;
    add_td(p, n, items, p.w_in_ab, (bf16*)(ws + WS_W1T), EVEN_IN, DM, 2 * FW, 0, 0);
    add_td(p, n, items, p.w_in_ab + 3 * FW + 8, (bf16*)(ws + WS_W1T), EVEN_IN, DM, FW, 0, 2 * FW);
    add_td(p, n, items, p.w_in_ab + 2 * FW, (bf16*)(ws + WS_WVT), EVEN_IN, DM, FW, 0, 0);
    add_td(p, n, items, p.w_glu, (bf16*)(ws + WS_WGLU), FW, FW, FW, 0, 0);
    add_td(p, n, items, p.w_out_ab, (bf16*)(ws + WS_WOUT), DM, DM, DM, 0, 0);
    add_td(p, n, items, p.w_in_c, (bf16*)(ws + WS_WC1T), ODD_IN, DM, DM + KVW, 0, 0);
    add_td(p, n, items, p.w_in_c + DM + KVW, (bf16*)(ws + WS_WCVT), ODD_IN, DM, KVW, 0, 0);
    add_td(p, n, items, p.w_out_c, (bf16*)(ws + WS_WOC), DM, DM, DM, 0, 0);
    for (int l = 0; l < 2; ++l) {
        if (l == 1) p.n_items_p0 = items;
        bf16* gu = (bf16*)(ws + (l == 0 ? WS_WGU0 : WS_WGU1)); bf16* dn = (bf16*)(ws + (l == 0 ? WS_WD0 : WS_WD1));
        add_td(p, n, items, p.w_gate + (size_t)l * DM * DFF, gu, DFF, DM, DFF, 1, 0);
        add_td(p, n, items, p.w_up + (size_t)l * DM * DFF, gu, DFF, DM, DFF, 1, 128);
        add_td(p, n, items, p.w_down + (size_t)l * DFF * DM, dn, DM, DFF, DM, 0, 0);
    }
    p.n_items = items;
    void* args[] = {&p};
    hipError_t e = hipLaunchCooperativeKernel((const void*)mega_fwd, dim3(grid), dim3(NTHR), args, LDS_BYTES, stream);
    if (e != hipSuccess) fprintf(stderr, "kernel_launch: cooperative launch failed: %s (grid %d)\n", hipGetErrorString(e), grid);
}
```

```cpp
#include <hip/hip_runtime.h>
#include <hip/hip_cooperative_groups.h>
#include <cstdio>
#include <cstdint>
#include <cstring>
namespace cg = cooperative_groups;
namespace pg8 {
#define PG8_LAS __attribute__((address_space(3)))
typedef unsigned short bf16_t;
typedef short bf16x8 __attribute__((ext_vector_type(8)));
typedef float f32x4 __attribute__((ext_vector_type(4)));
typedef unsigned u32x4 __attribute__((ext_vector_type(4)));
constexpr int BM = 256, BK = 64, HALF = 128, HTB = HALF * BK * 2  , STAGE_BYTES = 8 * HTB, NXCD = 8, WGM = 4;

__host__ __device__ __forceinline__ int lds_byte(int r, int c) { const int st = (r >> 4) * 2 + (c >> 5), rr = r & 15, cc = c & 31, ob = rr * 64 + cc * 2; return st * 1024 + (ob ^ (((ob >> 9) & 1) << 5)); }
__host__ __device__ __forceinline__ void stage_rc(int b, int& R, int& C) { const int st = b / 1024, sb = b % 1024, swz = sb ^ (((sb >> 9) & 1) << 5); R = (st >> 1) * 16 + swz / 64; C = (st & 1) * 32 + (swz % 64) / 2; }
__host__ __device__ __forceinline__ int perm32(int rho) { const int n = rho >> 4, i = rho & 15; return 8 * (i >> 2) + 4 * n + (i & 3); }

struct Unit { int pm, pn; };
struct Gemm { const bf16_t* A; const bf16_t* Bt; int M, N, K; };

struct StaticOrder {
    int nM, nN, nwg, G, c;
    __host__ __device__ void init(int M, int N, int G_, int c_) { nM = M / BM; nN = N / BM; nwg = nM * nN; G = G_; c = c_; }
    __host__ __device__ bool next(int i, Unit& u) const {
        const long L = (long)i * G + c; if (L >= nwg) return false;
        int wgid = (int)L; { const int q = nwg / NXCD, r = nwg % NXCD, xcd = wgid % NXCD, off = wgid / NXCD; wgid = (xcd < r ? xcd * (q + 1) : r * (q + 1) + (xcd - r) * q) + off; }
        const int nig = WGM * nN, gid = wgid / nig, fm = gid * WGM, gsz = (nM - fm) < WGM ? (nM - fm) : WGM;
        u.pm = fm + ((wgid % nig) % gsz); u.pn = (wgid % nig) / gsz; return true;
    }
    __device__ __forceinline__ void a_ready(const Unit&) const {}
    __device__ __forceinline__ void done(const Unit&) const {}
};

__device__ __forceinline__ unsigned cvt_pk_bf16(float lo, float hi) { unsigned r; asm volatile("v_cvt_pk_bf16_f32 %0, %1, %2" : "=v"(r) : "v"(lo), "v"(hi)); return r; }
typedef float f32x2 __attribute__((ext_vector_type(2)));
__device__ __forceinline__ f32x2 gelu_pk(f32x2 v) {
    const f32x2 av = __builtin_elementwise_abs(v), d = av * 0.2316418882f + 1.0f;
    f32x2 t; t.x = __builtin_amdgcn_rcpf(d.x); t.y = __builtin_amdgcn_rcpf(d.y);
    f32x2 q = t * 0.5307027145f + (-0.7265760135f); q = q * t + 0.7107068705f; q = q * t + (-0.142248368f); q = q * t + 0.127414796f; q = q * t;
    const f32x2 s = (v * v) * (-0.72134752044f);
    f32x2 e; e.x = __builtin_amdgcn_exp2f(s.x); e.y = __builtin_amdgcn_exp2f(s.y);
    const f32x2 m = v * (q * e), r = v - m;
    f32x2 o; o.x = v.x < 0.f ? m.x : r.x; o.y = v.y < 0.f ? m.y : r.y; return o;
}

template <int ACT  > struct EpiBf16 {
    static constexpr bool PERM = true, AFTER_DRAIN = false; static_assert(ACT == 0 || ACT == 1, "EpiBf16: ACT is 0 (none) or 1 (gelu_pk)");
    bf16_t* O; int ldc; const float* bias; int split_cols; size_t split_stride; float scale0;
    __device__ __forceinline__ void operator()(const f32x4 (&acc)[2][2][4][2], const Unit& u, int wr, int wc, int fr, int fq) const {
        const int row0 = u.pm * BM + wr * 64 + fr; int colt = u.pn * BM; bf16_t* base = O;
        float sc = 1.f; if (split_cols) { const int t = colt / split_cols; base += (size_t)t * split_stride; colt -= t * split_cols; if (t == 0) sc = scale0; }
        const int col0 = colt + wc * 32 + 8 * fq, bcol0 = u.pn * BM + wc * 32 + 8 * fq;
        f32x4 bv[2][2];
#pragma unroll
        for (int bj = 0; bj < 2; ++bj)
#pragma unroll
            for (int n = 0; n < 2; ++n) bv[bj][n] = bias ? *(const f32x4*)(bias + bcol0 + bj * HALF + 4 * n) : (f32x4){0.f, 0.f, 0.f, 0.f};
#pragma unroll
        for (int ai = 0; ai < 2; ++ai)
#pragma unroll
            for (int m = 0; m < 4; ++m) { bf16_t* rowp = base + (size_t)(row0 + ai * HALF + m * 16) * ldc + col0;
#pragma unroll
                for (int bj = 0; bj < 2; ++bj) { f32x4 v0 = acc[ai][bj][m][0] + bv[bj][0], v1 = acc[ai][bj][m][1] + bv[bj][1];
                    if (ACT == 1) { f32x2 a = gelu_pk((f32x2){v0[0], v0[1]}), b = gelu_pk((f32x2){v0[2], v0[3]}), c = gelu_pk((f32x2){v1[0], v1[1]}), d = gelu_pk((f32x2){v1[2], v1[3]});
                        v0 = (f32x4){a.x, a.y, b.x, b.y}; v1 = (f32x4){c.x, c.y, d.x, d.y}; }
                    v0 = v0 * sc; v1 = v1 * sc; u32x4 w; w.x = cvt_pk_bf16(v0[0], v0[1]); w.y = cvt_pk_bf16(v0[2], v0[3]); w.z = cvt_pk_bf16(v1[0], v1[1]); w.w = cvt_pk_bf16(v1[2], v1[3]);
                    *(u32x4*)(rowp + bj * HALF) = w; } }
    }
};
typedef unsigned u32x2 __attribute__((ext_vector_type(2)));
__device__ __forceinline__ float bf_lo(unsigned w) { return __builtin_bit_cast(float, w << 16); }
__device__ __forceinline__ float bf_hi(unsigned w) { return __builtin_bit_cast(float, w & 0xffff0000u); }
__device__ __forceinline__ float sigmoid_f(float v) { return __builtin_amdgcn_rcpf(1.0f + __builtin_amdgcn_exp2f(-1.4426950408889634f * v)); }

template <bool LNIN> struct EpiResidLN {
    static constexpr bool PERM = false, AFTER_DRAIN = false;
    const float* Xin; float* T; const float* gate; float alpha; int ldc; const float* stat_in; const float* lng; const float* lnb; float* stat_out;
    __device__ __forceinline__ void operator()(const f32x4 (&acc)[2][2][4][2], const Unit& u, int wr, int wc, int fr, int fq) const {
        const int col0 = u.pn * BM + wc * 32 + 4 * fq;
        f32x4 gv[2][2], lg[2][2], lb[2][2];
#pragma unroll
        for (int bj = 0; bj < 2; ++bj)
#pragma unroll
            for (int n = 0; n < 2; ++n) {
                gv[bj][n] = *(const f32x4*)(gate + col0 + bj * HALF + n * 16);
                if (LNIN) { lg[bj][n] = *(const f32x4*)(lng + col0 + bj * HALF + n * 16); lb[bj][n] = *(const f32x4*)(lnb + col0 + bj * HALF + n * 16); }
            }
#pragma unroll
        for (int ai = 0; ai < 2; ++ai)
#pragma unroll
            for (int m = 0; m < 4; ++m) {
                const int row = u.pm * BM + ai * HALF + wr * 64 + m * 16 + fr;
                const size_t off = (size_t)row * ldc + col0;
                float mean = 0.f, rstd = 1.f;
                if (LNIN) { const float s1 = stat_in[2 * row], s2 = stat_in[2 * row + 1]; mean = s1 * (1.0f / 2048.0f); const float var = s2 * (1.0f / 2048.0f) - mean * mean; rstd = 1.0f / sqrtf(var + 1e-5f); }
                float s = 0.f, ss = 0.f;
#pragma unroll
                for (int bj = 0; bj < 2; ++bj)
#pragma unroll
                    for (int n = 0; n < 2; ++n) {
                        f32x4 xv = *(const f32x4*)(Xin + off + bj * HALF + n * 16);
                        if (LNIN) xv = (xv - mean) * rstd * lg[bj][n] + lb[bj][n];
                        const f32x4 o = xv * alpha + gv[bj][n] * acc[ai][bj][m][n];
                        *(f32x4*)(T + off + bj * HALF + n * 16) = o;
                        s += (o[0] + o[1]) + (o[2] + o[3]); ss += (o[0] * o[0] + o[1] * o[1]) + (o[2] * o[2] + o[3] * o[3]);
                    }
                s += __shfl_xor(s, 16); s += __shfl_xor(s, 32); ss += __shfl_xor(ss, 16); ss += __shfl_xor(ss, 32);
                if (fq == 0) { atomicAdd(stat_out + 2 * row, s); atomicAdd(stat_out + 2 * row + 1, ss); }
                asm volatile("" ::: "memory");
            }
    }
};

struct PanelOrder {
    int c;
    __host__ __device__ void init(int c_) { c = c_; }
    __host__ __device__ bool next(int i, Unit& u) const { if (i >= 2) return false; const int j = c >> 3; u.pm = 8 * (c & 7) + 4 * i + (j & 3); u.pn = j >> 2; return true; }
    __device__ __forceinline__ void a_ready(const Unit&) const {}
    __device__ __forceinline__ void done(const Unit&) const {}
};
template <bool LNIN, bool FINAL> struct EpiResidLNF {
    static constexpr bool PERM = false, AFTER_DRAIN = false;
    const float* Xin; float* T; const float* gate; float alpha; int ldc; const float* stat_in; const float* lng_in; const float* lnb_in;
    float* stat_out; unsigned* cnt; const float* lng; const float* lnb; const float* sh; const float* sc; bf16_t* H; float* OUT;
    __device__ __forceinline__ void operator()(const f32x4 (&acc_)[2][2][4][2], const Unit& u, int wr, int wc, int fr, int fq) const {
        f32x4 (&acc)[2][2][4][2] = const_cast<f32x4 (&)[2][2][4][2]>(acc_);
        asm volatile("" : "+v"(fr), "+v"(fq));
        const int col0 = u.pn * BM + wc * 32 + 4 * fq;
        {
#pragma unroll
            for (int ai = 0; ai < 2; ++ai)
#pragma unroll
                for (int m = 0; m < 4; ++m) {
                    const int row = u.pm * BM + ai * HALF + wr * 64 + m * 16 + fr;
                    const size_t off = (size_t)row * ldc + col0;
                    float mean = 0.f, rstd = 1.f;
                    if (LNIN) { const float s1 = stat_in[2 * row], s2 = stat_in[2 * row + 1]; mean = s1 * (1.0f / 2048.0f); const float var = s2 * (1.0f / 2048.0f) - mean * mean; rstd = 1.0f / sqrtf(var + 1e-5f); }
                    float s = 0.f, ss = 0.f;
#pragma unroll
                    for (int bj = 0; bj < 2; ++bj)
#pragma unroll
                        for (int n = 0; n < 2; ++n) {
                            f32x4 xv = *(const f32x4*)(Xin + off + bj * HALF + n * 16);
                            const int cc = col0 + bj * HALF + n * 16;
                            if (LNIN) xv = (xv - mean) * rstd * *(const f32x4*)(lng_in + cc) + *(const f32x4*)(lnb_in + cc);
                            const f32x4 o = xv * alpha + *(const f32x4*)(gate + cc) * acc[ai][bj][m][n];
                            acc[ai][bj][m][n] = o;
                            if (!FINAL) *(f32x4*)(T + off + bj * HALF + n * 16) = o;
                            s += (o[0] + o[1]) + (o[2] + o[3]); ss += (o[0] * o[0] + o[1] * o[1]) + (o[2] * o[2] + o[3] * o[3]);
                        }
                    s += __shfl_xor(s, 16); s += __shfl_xor(s, 32); ss += __shfl_xor(ss, 16); ss += __shfl_xor(ss, 32);
                    if (fq == 0) { atomicAdd(stat_out + 2 * row, s); atomicAdd(stat_out + 2 * row + 1, ss); }
                    if (m == 3) asm volatile("" ::: "memory");
                }
        }
        f32x4 a2[2][2], b2[2][2];
#pragma unroll
        for (int bj = 0; bj < 2; ++bj)
#pragma unroll
            for (int n = 0; n < 2; ++n) {
                const int cc = col0 + bj * HALF + n * 16;
                a2[bj][n] = *(const f32x4*)(lng + cc); b2[bj][n] = *(const f32x4*)(lnb + cc);
                if (!FINAL) { const f32x4 s1 = *(const f32x4*)(sc + cc) + 1.0f; a2[bj][n] = a2[bj][n] * s1; b2[bj][n] = b2[bj][n] * s1 + *(const f32x4*)(sh + cc); }
            }
        asm volatile("s_waitcnt vmcnt(0) lgkmcnt(0)" ::: "memory");
        unsigned* c = cnt + 64 * u.pm;
        if ((threadIdx.x & 63) == 0) __hip_atomic_fetch_add(c, 1u, __ATOMIC_RELAXED, __HIP_MEMORY_SCOPE_AGENT);
        if (__builtin_amdgcn_readfirstlane(threadIdx.x >> 6) == 0) {
            unsigned spins = 0;
            while ((unsigned)__builtin_amdgcn_readfirstlane(__hip_atomic_load(c, __ATOMIC_RELAXED, __HIP_MEMORY_SCOPE_AGENT)) < 64u) {
                __builtin_amdgcn_s_sleep(4);
                if (++spins > (1u << 23)) break;
            }
        }
        __builtin_amdgcn_s_barrier();
        asm volatile("" ::: "memory");
        float mean8[8], rstd8[8];
#pragma unroll
        for (int ai = 0; ai < 2; ++ai)
#pragma unroll
            for (int m = 0; m < 4; ++m) {
                const int row = u.pm * BM + ai * HALF + wr * 64 + m * 16 + fr;
                const float s1 = __hip_atomic_load(stat_out + 2 * row, __ATOMIC_RELAXED, __HIP_MEMORY_SCOPE_AGENT), s2 = __hip_atomic_load(stat_out + 2 * row + 1, __ATOMIC_RELAXED, __HIP_MEMORY_SCOPE_AGENT);
                const float mean = s1 * (1.0f / 2048.0f), var = s2 * (1.0f / 2048.0f) - mean * mean;
                mean8[ai * 4 + m] = mean; rstd8[ai * 4 + m] = 1.0f / sqrtf(var + 1e-5f);
            }
#pragma unroll
        for (int bj = 0; bj < 2; ++bj)
#pragma unroll
            for (int n = 0; n < 2; ++n) {
                const int cc = col0 + bj * HALF + n * 16;
#pragma unroll
                for (int ai = 0; ai < 2; ++ai)
#pragma unroll
                    for (int m = 0; m < 4; ++m) {
                        const size_t off = (size_t)(u.pm * BM + ai * HALF + wr * 64 + m * 16 + fr) * ldc + cc;
                        const f32x4 y = (acc[ai][bj][m][n] - mean8[ai * 4 + m]) * rstd8[ai * 4 + m] * a2[bj][n] + b2[bj][n];
                        if (FINAL) *(f32x4*)(OUT + off) = y;
                        else { u32x2 w; w.x = cvt_pk_bf16(y[0], y[1]); w.y = cvt_pk_bf16(y[2], y[3]); *(u32x2*)(H + off) = w; }
                    }
                asm volatile("" ::: "memory");
            }
    }
};

struct EpiSwiglu {
    static constexpr bool PERM = true, AFTER_DRAIN = false;
    bf16_t* O; int ldo;
    __device__ __forceinline__ void operator()(const f32x4 (&acc)[2][2][4][2], const Unit& u, int wr, int wc, int fr, int fq) const {
        const int row0 = u.pm * BM + wr * 64 + fr, col0 = u.pn * HALF + wc * 32 + 8 * fq;
#pragma unroll
        for (int ai = 0; ai < 2; ++ai)
#pragma unroll
            for (int m = 0; m < 4; ++m) {
                bf16_t* rowp = O + (size_t)(row0 + ai * HALF + m * 16) * ldo + col0;
                float v[8];
#pragma unroll
                for (int n = 0; n < 2; ++n)
#pragma unroll
                    for (int i = 0; i < 4; ++i) { const float gt = acc[ai][0][m][n][i], up = acc[ai][1][m][n][i]; v[4 * n + i] = gt * sigmoid_f(gt) * up; }
                u32x4 w; w.x = cvt_pk_bf16(v[0], v[1]); w.y = cvt_pk_bf16(v[2], v[3]); w.z = cvt_pk_bf16(v[4], v[5]); w.w = cvt_pk_bf16(v[6], v[7]);
                *(u32x4*)rowp = w;
            }
    }
};

struct EpiGlu {
    static constexpr bool PERM = true, AFTER_DRAIN = false;
    const bf16_t* S; int lds_; const float* b; bf16_t* O; int ldo; int ocol0;
    __device__ __forceinline__ void operator()(const f32x4 (&acc)[2][2][4][2], const Unit& u, int wr, int wc, int fr, int fq) const {
        const int row0 = u.pm * BM + wr * 64 + fr, col0 = u.pn * BM + wc * 32 + 8 * fq;
        f32x4 bv[2][2];
#pragma unroll
        for (int bj = 0; bj < 2; ++bj)
#pragma unroll
            for (int n = 0; n < 2; ++n) bv[bj][n] = *(const f32x4*)(b + col0 + bj * HALF + 4 * n);
#pragma unroll
        for (int ai = 0; ai < 2; ++ai)
#pragma unroll
            for (int m = 0; m < 4; ++m) {
                const size_t row = (size_t)(row0 + ai * HALF + m * 16);
#pragma unroll
                for (int bj = 0; bj < 2; ++bj) {
                    const u32x4 sw = *(const u32x4*)(S + row * lds_ + col0 + bj * HALF);
                    const f32x4 z0 = acc[ai][bj][m][0] + bv[bj][0], z1 = acc[ai][bj][m][1] + bv[bj][1];
                    u32x4 w;
                    w.x = cvt_pk_bf16(bf_lo(sw.x) * sigmoid_f(z0[0]), bf_hi(sw.x) * sigmoid_f(z0[1]));
                    w.y = cvt_pk_bf16(bf_lo(sw.y) * sigmoid_f(z0[2]), bf_hi(sw.y) * sigmoid_f(z0[3]));
                    w.z = cvt_pk_bf16(bf_lo(sw.z) * sigmoid_f(z1[0]), bf_hi(sw.z) * sigmoid_f(z1[1]));
                    w.w = cvt_pk_bf16(bf_lo(sw.w) * sigmoid_f(z1[2]), bf_hi(sw.w) * sigmoid_f(z1[3]));
                    *(u32x4*)(O + row * ldo + ocol0 + col0 + bj * HALF) = w;
                }
                asm volatile("" ::: "memory");
            }
    }
};

struct EpiQKRot {
    static constexpr bool PERM = true, AFTER_DRAIN = false;
    bf16_t* O0; int ld0; int nt0; float scale0; bf16_t* O1; int ld1; const float* COS; const float* SIN;
    __device__ __forceinline__ void operator()(const f32x4 (&acc)[2][2][4][2], const Unit& u, int wr, int wc, int fr, int fq) const {
        const int row0 = u.pm * BM + wr * 64 + fr;
        const bool first = u.pn < nt0;
        bf16_t* base = first ? O0 : O1; const int ld = first ? ld0 : ld1; const float sc = first ? scale0 : 1.0f;
        const int col0 = (first ? u.pn : u.pn - nt0) * BM + wc * 32 + 8 * fq;
        const bool rotw = (wc & 1) == 0;
#pragma unroll
        for (int ai = 0; ai < 2; ++ai)
#pragma unroll
            for (int m = 0; m < 4; ++m) {
                const size_t row = (size_t)(row0 + ai * HALF + m * 16);
                f32x4 cs[2], sn[2];
                if (rotw) {
#pragma unroll
                    for (int n = 0; n < 2; ++n) { cs[n] = *(const f32x4*)(COS + row * 8 + 4 * n); sn[n] = *(const f32x4*)(SIN + row * 8 + 4 * n); }
                }
#pragma unroll
                for (int bj = 0; bj < 2; ++bj) {
                    f32x4 v0 = acc[ai][bj][m][0], v1 = acc[ai][bj][m][1];
                    if (rotw) {
                        f32x4 p0, p1;
#pragma unroll
                        for (int i = 0; i < 4; ++i) { p0[i] = __shfl_xor(v0[i], 16); p1[i] = __shfl_xor(v1[i], 16); }
                        if (fq == 0) { v0 = v0 * cs[0] - p0 * sn[0]; v1 = v1 * cs[1] - p1 * sn[1]; }
                        else if (fq == 1) { v0 = v0 * cs[0] + p0 * sn[0]; v1 = v1 * cs[1] + p1 * sn[1]; }
                    }
                    v0 = v0 * sc; v1 = v1 * sc;
                    u32x4 w; w.x = cvt_pk_bf16(v0[0], v0[1]); w.y = cvt_pk_bf16(v0[2], v0[3]); w.z = cvt_pk_bf16(v1[0], v1[1]); w.w = cvt_pk_bf16(v1[2], v1[3]);
                    *(u32x4*)(base + row * ld + col0 + bj * HALF) = w;
                }
                asm volatile("" ::: "memory");
            }
    }
};
template <class Epi, class Sched, bool ALIGN_EPI = false, bool SP2 = false>
__device__ __forceinline__ void gemm_phase(PG8_LAS unsigned char* lds, const Gemm g, const Sched& S, const Epi& E) {
    int tid_ = threadIdx.x; asm volatile("" : "+v"(tid_));
    const int tid = tid_, wid = __builtin_amdgcn_readfirstlane(tid >> 6), lane = tid & 63, wr = wid >> 2, wc = wid & 3, fr = lane & 15, fq = lane >> 4;
    const int K = g.K, nt = K / BK;
    unsigned voffA[2], voffB[2];
#pragma unroll
    for (int i = 0; i < 2; ++i) { int R, C; stage_rc(tid * 16 + i * 8192, R, C); const int Rb = Epi::PERM ? ((R & ~31) + perm32(R & 31)) : R;
        voffA[i] = (unsigned)(R * K + C) * 2u; voffB[i] = (unsigned)(Rb * K + C) * 2u; }
    const size_t kstep = (size_t)(BK * 2);
    const size_t hstep = (size_t)HALF * K * 2;
    const size_t tstep = 2 * hstep;
    const unsigned ldsw = (unsigned)wid * 1024u;
    const int aoff = lds_byte(wr * 64 + fr, fq * 8), boff = lds_byte(wc * 32 + fr, fq * 8);
#define PG8_SA(b, h) (((b) * 2 + (h)) * HTB)
#define PG8_SB(b, h) ((4 + (b) * 2 + (h)) * HTB)
#define PG8_STAGE(bufoff, gbase, voff) do { _Pragma("unroll") for (int _i = 0; _i < 2; ++_i) \
        __builtin_amdgcn_global_load_lds((const unsigned*)((const char*)(gbase) + (voff)[_i]), (PG8_LAS unsigned*)(lds + (bufoff) + ldsw + _i * 8192), 16, 0, 0); } while (0)
#define PG8_LDA(dst, b, h) do { _Pragma("unroll") for (int m = 0; m < 4; ++m) _Pragma("unroll") for (int k = 0; k < 2; ++k) dst[m][k] = *(const PG8_LAS bf16x8*)(lds + PG8_SA(b, h) + aoff + m * 2048 + k * 1024); } while (0)
#define PG8_LDB(dst, b, h) do { _Pragma("unroll") for (int n = 0; n < 2; ++n) _Pragma("unroll") for (int k = 0; k < 2; ++k) dst[n][k] = *(const PG8_LAS bf16x8*)(lds + PG8_SB(b, h) + boff + n * 2048 + k * 1024); } while (0)
#define PG8_MMA(ai, bj, At, Bt) do { __builtin_amdgcn_s_setprio(1); _Pragma("unroll") for (int m = 0; m < 4; ++m) _Pragma("unroll") for (int n = 0; n < 2; ++n) _Pragma("unroll") for (int k = 0; k < 2; ++k) \
        acc[ai][bj][m][n] = __builtin_amdgcn_mfma_f32_16x16x32_bf16(Bt[n][k], At[m][k], acc[ai][bj][m][n], 0, 0, 0); __builtin_amdgcn_s_setprio(0); } while (0)
#define PG8_WAIT_V(n) asm volatile("s_waitcnt vmcnt(" #n ")" ::: "memory")
#define PG8_WAIT_L(n) asm volatile("s_waitcnt lgkmcnt(" #n ")" ::: "memory")
#define PG8_BAR __builtin_amdgcn_s_barrier()
#define PG8_SCHED __builtin_amdgcn_sched_barrier(0)
    Unit cur, nxt; int ui = 0;
    if (!S.next(0, cur)) return;
    f32x4 acc[2][2][4][2];
#pragma unroll
    for (int a = 0; a < 2; ++a)
#pragma unroll
        for (int b = 0; b < 2; ++b)
#pragma unroll
            for (int m = 0; m < 4; ++m)
#pragma unroll
                for (int n = 0; n < 2; ++n) acc[a][b][m][n] = (f32x4){0.f, 0.f, 0.f, 0.f};
    bf16x8 At[4][2], B0[2][2], B1[2][2];
    const char* cA = (const char*)g.A + (size_t)cur.pm * tstep; const char* cB = (const char*)g.Bt + (size_t)cur.pn * tstep;
    S.a_ready(cur);
    if constexpr (SP2) {
        PG8_STAGE(PG8_SB(0, 0), cB, voffB); PG8_STAGE(PG8_SB(0, 1), cB + hstep, voffB); PG8_STAGE(PG8_SA(0, 0), cA, voffA); PG8_STAGE(PG8_SA(0, 1), cA + hstep, voffA);
        if (wr == 1) PG8_BAR;
        PG8_WAIT_V(2); PG8_BAR;
        PG8_STAGE(PG8_SB(1, 0), cB + kstep, voffB); PG8_STAGE(PG8_SA(1, 0), cA + kstep, voffA); PG8_STAGE(PG8_SB(1, 1), cB + hstep + kstep, voffB);
        PG8_WAIT_V(6); PG8_BAR;
    } else {
        PG8_STAGE(PG8_SB(0, 0), cB, voffB); PG8_STAGE(PG8_SA(0, 0), cA, voffA); PG8_STAGE(PG8_SB(0, 1), cB + hstep, voffB); PG8_STAGE(PG8_SA(0, 1), cA + hstep, voffA);
        if (wr == 1) PG8_BAR;
        PG8_WAIT_V(4); PG8_BAR;
        PG8_STAGE(PG8_SB(1, 0), cB + kstep, voffB); PG8_STAGE(PG8_SA(1, 0), cA + kstep, voffA); PG8_STAGE(PG8_SB(1, 1), cB + hstep + kstep, voffB);
        PG8_WAIT_V(6); PG8_BAR;
    }
    for (;;) {
        const bool has_next = S.next(ui + 1, nxt);
        const char* nA = has_next ? (const char*)g.A + (size_t)nxt.pm * tstep : cA; const char* nB = has_next ? (const char*)g.Bt + (size_t)nxt.pn * tstep : cB;
        for (int t = 0; t < nt; t += 2) {
            const bool last = (t == nt - 2);
            const char* a1 = cA + (size_t)(t + 1) * kstep;
            const char* a2 = last ? nA : cA + (size_t)(t + 2) * kstep; const char* b2 = last ? nB : cB + (size_t)(t + 2) * kstep;
            const char* a3 = a2 + kstep; const char* b3 = b2 + kstep;
            if (last && has_next) S.a_ready(nxt);
            if constexpr (SP2) {
            PG8_LDB(B0, 0, 0); PG8_LDB(B1, 0, 1); PG8_SCHED; PG8_LDA(At, 0, 0); PG8_STAGE(PG8_SA(1, 1), a1 + hstep, voffA);
            PG8_WAIT_V(8); PG8_WAIT_L(0); PG8_BAR; PG8_MMA(0, 0, At, B0); PG8_MMA(0, 1, At, B1); PG8_BAR; PG8_SCHED;
            PG8_LDA(At, 0, 1); PG8_STAGE(PG8_SB(0, 0), b2, voffB); PG8_STAGE(PG8_SB(0, 1), b2 + hstep, voffB); PG8_STAGE(PG8_SA(0, 0), a2, voffA);
            PG8_WAIT_V(8); PG8_WAIT_L(0); PG8_BAR; PG8_MMA(1, 0, At, B0); PG8_MMA(1, 1, At, B1); PG8_BAR; PG8_SCHED;
            PG8_LDB(B0, 1, 0); PG8_LDB(B1, 1, 1); PG8_SCHED; PG8_LDA(At, 1, 0); PG8_STAGE(PG8_SA(0, 1), a2 + hstep, voffA);
            PG8_WAIT_V(8); PG8_WAIT_L(0); PG8_BAR; PG8_MMA(0, 0, At, B0); PG8_MMA(0, 1, At, B1); PG8_BAR; PG8_SCHED;
            PG8_LDA(At, 1, 1); PG8_STAGE(PG8_SB(1, 0), b3, voffB); PG8_STAGE(PG8_SB(1, 1), b3 + hstep, voffB); PG8_STAGE(PG8_SA(1, 0), a3, voffA);
            PG8_WAIT_V(8); PG8_WAIT_L(0); PG8_BAR; PG8_MMA(1, 0, At, B0); PG8_MMA(1, 1, At, B1); PG8_BAR; PG8_SCHED;
            } else {
            PG8_LDB(B0, 0, 0); PG8_SCHED; PG8_LDA(At, 0, 0); PG8_STAGE(PG8_SA(1, 1), a1 + hstep, voffA);
            PG8_WAIT_L(8); PG8_BAR; PG8_WAIT_L(0); PG8_MMA(0, 0, At, B0); PG8_BAR; PG8_SCHED;
            PG8_LDB(B1, 0, 1); PG8_STAGE(PG8_SB(0, 0), b2, voffB);
            PG8_BAR; PG8_WAIT_L(0); PG8_MMA(0, 1, At, B1); PG8_BAR;
            PG8_LDA(At, 0, 1); PG8_STAGE(PG8_SA(0, 0), a2, voffA);
            PG8_BAR; PG8_WAIT_L(0); PG8_MMA(1, 0, At, B0); PG8_BAR; PG8_SCHED;
            PG8_STAGE(PG8_SB(0, 1), b2 + hstep, voffB);
            PG8_WAIT_V(6); PG8_BAR; PG8_MMA(1, 1, At, B1); PG8_BAR;
            PG8_LDB(B0, 1, 0); PG8_SCHED; PG8_LDA(At, 1, 0); PG8_STAGE(PG8_SA(0, 1), a2 + hstep, voffA);
            PG8_WAIT_L(8); PG8_BAR; PG8_WAIT_L(0); PG8_MMA(0, 0, At, B0); PG8_BAR; PG8_SCHED;
            PG8_LDB(B1, 1, 1); PG8_STAGE(PG8_SB(1, 0), b3, voffB);
            PG8_BAR; PG8_WAIT_L(0); PG8_MMA(0, 1, At, B1); PG8_BAR;
            PG8_LDA(At, 1, 1); PG8_STAGE(PG8_SA(1, 0), a3, voffA);
            PG8_BAR; PG8_WAIT_L(0); PG8_MMA(1, 0, At, B0); PG8_BAR; PG8_SCHED;
            PG8_STAGE(PG8_SB(1, 1), b3 + hstep, voffB);
            PG8_WAIT_V(6); PG8_BAR; PG8_MMA(1, 1, At, B1); PG8_BAR;
            }
        }
        if constexpr (ALIGN_EPI) { if (wr == 0) PG8_BAR; }
        if constexpr (!Epi::AFTER_DRAIN) { E(acc, cur, wr, wc, fr, fq); S.done(cur); }
        if (!has_next) break;
#pragma unroll
        for (int a = 0; a < 2; ++a)
#pragma unroll
            for (int b = 0; b < 2; ++b)
#pragma unroll
                for (int m = 0; m < 4; ++m)
#pragma unroll
                    for (int n = 0; n < 2; ++n) acc[a][b][m][n] = (f32x4){0.f, 0.f, 0.f, 0.f};
        cur = nxt; cA = nA; cB = nB; ++ui;
        if constexpr (ALIGN_EPI) { if (wr == 1) PG8_BAR; }
    }
    PG8_WAIT_V(0);
    if constexpr (!ALIGN_EPI) { if (wr == 0) PG8_BAR; }
    PG8_BAR;
    if constexpr (Epi::AFTER_DRAIN) { E.fused(acc, cur, wr, wc, fr, fq, lds, wid, lane); S.done(cur); }
#undef PG8_SA
#undef PG8_SB
#undef PG8_STAGE
#undef PG8_LDA
#undef PG8_LDB
#undef PG8_MMA
#undef PG8_WAIT_V
#undef PG8_WAIT_L
#undef PG8_BAR
#undef PG8_SCHED
}
}
#define LAS __attribute__((address_space(3)))
typedef unsigned short bf16;
typedef float f32x4 __attribute__((ext_vector_type(4)));
typedef float f32x2 __attribute__((ext_vector_type(2)));
typedef float f32x16 __attribute__((ext_vector_type(16)));
typedef short bf16x8 __attribute__((ext_vector_type(8)));
typedef short s16x4 __attribute__((ext_vector_type(4)));
typedef unsigned u32x4 __attribute__((ext_vector_type(4)));
typedef unsigned u32x2 __attribute__((ext_vector_type(2)));

constexpr int M = 16384, DM = 2048, FW = 1024, EVEN_IN = 4104, ODD_IN = 2560, KVW = 256, DFF = 5632;
constexpr int NWAVES = 8, NTHR = 512;
constexpr float LN_EPS = 1e-5f;
constexpr float ALPHA = 1.4142135623730951f;
constexpr float LOG2E = 1.4426950408889634f;
constexpr int LDS_BYTES = 147456;
constexpr int LDS_BARST = LDS_BYTES - 16;
#define VCU(lds) (((volatile LAS unsigned*)((lds) + LDS_BARST))[2])

constexpr size_t MiB = 1u << 20;
constexpr size_t WS_MOD = 0;
constexpr size_t CTL_ZERO_BYTES = 2 * MiB;
constexpr size_t WS_PCNT = 1 * MiB + 512 * 1024;
constexpr size_t WS_STAT = 1 * MiB;
constexpr int CW_KMAX2 = 24576, CW_QN2 = 24640;
constexpr size_t WS_W1T = 2 * MiB, WS_WVT = 14 * MiB, WS_WGLU = 18 * MiB, WS_WOUT = 20 * MiB, WS_WC1T = 28 * MiB, WS_WCVT = 38 * MiB, WS_WOC = 40 * MiB;
constexpr size_t WS_WGU0 = 48 * MiB, WS_WGU1 = 92 * MiB, WS_WD0 = 136 * MiB, WS_WD1 = 158 * MiB;
constexpr size_t WS_H = 180 * MiB;
constexpr size_t WS_R = 244 * MiB;
constexpr size_t WS_Q = WS_R, WS_K = WS_R + 32 * MiB, WS_U = WS_R + 64 * MiB, WS_VT = WS_R + 96 * MiB, WS_S = WS_R + 128 * MiB, WS_MIX = WS_R + 160 * MiB;
constexpr size_t WS_MID = WS_R;
constexpr size_t WS_Q2 = WS_R, WS_K2 = WS_R + 64 * MiB, WS_VT2 = WS_R + 72 * MiB;
constexpr size_t WS_E = 468 * MiB;
constexpr size_t WS_LOGF = 476 * MiB, WS_F = WS_LOGF + MiB / 2, WS_COS = 477 * MiB, WS_SIN = WS_COS + MiB / 2;
constexpr size_t WS_END = 478 * MiB;

struct TDesc { const float* src; bf16* dst; int ld, K, ncols, mode, row_off, first; };
constexpr int NTD = 14;
struct Params {
    const float *x, *c; const int* pos;
    const float *w_in_ab, *b_forget, *lam_re, *lam_im, *log_dt, *b_re, *b_im, *c_re, *c_im, *ssm_d, *w_glu, *b_glu, *w_out_ab, *w_in_c, *sinks, *w_out_c,
        *w_ada, *b_ada, *ln_mix_g, *ln_mix_b, *ln_ffn_g, *ln_ffn_b, *w_gate, *w_up, *w_down;
    float* out; unsigned char* ws;
    TDesc td[NTD]; int n_items; int n_items_p0;
};

__device__ __forceinline__ unsigned f2bf(float f) { unsigned u = __builtin_bit_cast(unsigned, f); return (u + 0x7fffu + ((u >> 16) & 1u)) >> 16; }
__device__ __forceinline__ unsigned pk2(float lo, float hi) { return f2bf(lo) | (f2bf(hi) << 16); }
__device__ __forceinline__ float bflo(unsigned w) { return __builtin_bit_cast(float, w << 16); }
__device__ __forceinline__ float bfhi(unsigned w) { return __builtin_bit_cast(float, w & 0xffff0000u); }
__device__ __forceinline__ float wave_sum(float v) {
#pragma unroll
    for (int o = 1; o < 64; o <<= 1) v += __shfl_xor(v, o);
    return v;
}
__device__ __forceinline__ void sincos_d(double ang, double& s, double& c) {
    const double TWO_PI = 6.283185307179586476925287, INV_TWO_PI = 0.159154943091895335768884;
    const double k = __builtin_rint(ang * INV_TWO_PI);
    const double r = __builtin_fma(-k, TWO_PI, ang) - k * 2.449293598294706e-16;
    const double r2 = r * r;
    double ss = 1.0 / 1.0888869450418352e28;
    double cc = 1.0 / 4.0329146112660565e26;
    const double fs[13] = {1.0 / 1.5511210043330986e25, 1.0 / 2.5852016738884978e22, 1.0 / 5.109094217170944e19, 1.0 / 1.21645100408832e17, 1.0 / 355687428096000.0, 1.0 / 1307674368000.0,
                           1.0 / 6227020800.0, 1.0 / 39916800.0, 1.0 / 362880.0, 1.0 / 5040.0, 1.0 / 120.0, 1.0 / 6.0, 1.0};
    const double fc[13] = {1.0 / 6.204484017332394e23, 1.0 / 1.1240007277776077e21, 1.0 / 2.43290200817664e18, 1.0 / 6402373705728000.0, 1.0 / 20922789888000.0, 1.0 / 87178291200.0,
                           1.0 / 479001600.0, 1.0 / 3628800.0, 1.0 / 40320.0, 1.0 / 720.0, 1.0 / 24.0, 1.0 / 2.0, 1.0};
#pragma unroll
    for (int i = 0; i < 13; ++i) { ss = fs[i] - ss * r2; cc = fc[i] - cc * r2; }
    s = ss * r; c = cc;
}

__device__ __forceinline__ void transpose_item(const TDesc& d, LAS float* scr, int item, int lane) {
    const int nblk = d.ncols / 32, kb = item / nblk, nb = item % nblk, k0 = 64 * kb, n0 = 32 * nb;
    const float* W = d.src;
#pragma unroll
    for (int i = 0; i < 32; ++i) { const int kk = 2 * i + (lane >> 5); scr[kk * 33 + (lane & 31)] = W[(size_t)(k0 + kk) * d.ld + n0 + (lane & 31)]; }
    asm volatile("s_waitcnt lgkmcnt(0)" ::: "memory");
    const int c = lane & 7;
    const int drow0 = (d.mode == 0) ? (d.row_off + n0) : ((n0 >> 7) * 256 + (n0 & 127) + d.row_off);
#pragma unroll
    for (int j = 0; j < 4; ++j) { const int n = (lane >> 3) + 8 * j; const LAS float* s = scr + (8 * c) * 33 + n;
        u32x4 o; o.x = pk2(s[0 * 33], s[1 * 33]); o.y = pk2(s[2 * 33], s[3 * 33]); o.z = pk2(s[4 * 33], s[5 * 33]); o.w = pk2(s[6 * 33], s[7 * 33]);
        *(u32x4*)(d.dst + (size_t)(drow0 + n) * d.K + k0 + 8 * c) = o; }
    asm volatile("s_waitcnt lgkmcnt(0)" ::: "memory");
}

__device__ __forceinline__ void convert_items(const Params& P, LAS float* scr, int it_lo, int it_hi, int w, int nw, int lane) {
    for (int it = it_lo + w; it < it_hi; it += nw) {
        int di = 0;
#pragma unroll
        for (int j = 1; j < NTD; ++j) di = (it >= P.td[j].first) ? j : di;
        const TDesc d = P.td[di];
        transpose_item(d, scr, it - d.first, lane);
    }
}
__device__ __forceinline__ void p0_prologue(const Params& P, LAS unsigned char* lds, int wave, int lane) {
    LAS float* scr = (LAS float*)(lds + wave * 16384);
    const int gw = blockIdx.x * NWAVES + wave, NGW = gridDim.x * NWAVES;
    float* mod = (float*)(P.ws + WS_MOD);
    for (int it = gw; it < 96 * 64; it += NGW) {
        const int nb = it % 96, ks = it / 96, l = nb / 48, n0 = (nb % 48) * 256 + 4 * lane;
        const float* W = P.w_ada + ((size_t)l * DM + ks * 32) * 12288 + n0;
        f32x4 acc = {0.f, 0.f, 0.f, 0.f};
#pragma unroll
        for (int k = 0; k < 32; ++k) { const float cv = P.c[ks * 32 + k]; const float sv = cv * __builtin_amdgcn_rcpf(1.0f + __expf(-cv)); const f32x4 w = *(const f32x4*)(W + (size_t)k * 12288); acc += w * sv; }
        if (ks == 0) acc += *(const f32x4*)(P.b_ada + l * 12288 + n0);
        float* o = mod + l * 12288 + n0;
        atomicAdd(o + 0, acc[0]); atomicAdd(o + 1, acc[1]); atomicAdd(o + 2, acc[2]); atomicAdd(o + 3, acc[3]);
    }
    {
        float* COS = (float*)(P.ws + WS_COS); float* SIN = (float*)(P.ws + WS_SIN);
        const double inv_freq[8] = {1.0, 0.19392274474868576, 0.03760603093086393, 0.007292664737217109, 0.001414213562373095, 0.0002742481756762073, 5.318295896944988e-05, 1.031338537721246e-05};
        for (int e = blockIdx.x * NTHR + threadIdx.x; e < M * 8; e += gridDim.x * NTHR) {
            const int t = e >> 3, i = e & 7;
            double fr = inv_freq[0];
#pragma unroll
            for (int j = 1; j < 8; ++j) fr = (i == j) ? inv_freq[j] : fr;
            const double ang = (double)P.pos[t] * fr;
            double s, c; sincos_d(ang, s, c);
            COS[e] = (float)c; SIN[e] = (float)s;
        }
    }
    convert_items(P, scr, 0, P.n_items_p0, gw, NGW, lane);
}

__device__ __forceinline__ float log_sigmoid_f(float z) { return (z >= 0.f) ? -log1pf(__expf(-z)) : (z - log1pf(__expf(z))); }
__device__ __forceinline__ void hprep_phase(const Params& P, LAS unsigned char* lds, int wave, int lane) {
    LAS float* SC1 = (LAS float*)lds; LAS float* SH = SC1 + DM; LAS float* WF = SH + DM;
    const float* mod = (const float*)(P.ws + WS_MOD);
    for (int i = threadIdx.x; i < DM; i += NTHR) { SH[i] = mod[i]; SC1[i] = 1.0f + mod[DM + i]; }
    for (int i = threadIdx.x; i < DM * 8; i += NTHR) WF[(i & 7) * DM + (i >> 3)] = P.w_in_ab[(size_t)(i >> 3) * EVEN_IN + 3 * FW + (i & 7)];
    __syncthreads();
    bf16* H = (bf16*)(P.ws + WS_H); float* LOGF = (float*)(P.ws + WS_LOGF);
    const int gw = blockIdx.x * NWAVES + wave, NGW = gridDim.x * NWAVES;
    for (int m = gw; m < M; m += NGW) {
        const f32x4* xr = (const f32x4*)(P.x + (size_t)m * DM) + lane;
        float fl[8];
#pragma unroll
        for (int j = 0; j < 8; ++j) fl[j] = 0.f;
        unsigned long long* o8 = (unsigned long long*)(H + (size_t)m * DM) + lane;
        f32x4 xv[8];
#pragma unroll
        for (int j = 0; j < 8; ++j) xv[j] = xr[64 * j];
#pragma unroll 2
        for (int j = 0; j < 8; ++j) {
            f32x4 v = xv[j];
            const f32x4 s1 = *(const LAS f32x4*)(SC1 + 4 * lane + 256 * j), sh = *(const LAS f32x4*)(SH + 4 * lane + 256 * j);
            v = v * s1 + sh;
            o8[64 * j] = (unsigned long long)pk2(v[0], v[1]) | ((unsigned long long)pk2(v[2], v[3]) << 32);
#pragma unroll
            for (int jf = 0; jf < 8; ++jf) {
                const f32x4 w = *(const LAS f32x4*)(WF + jf * DM + 4 * lane + 256 * j);
                fl[jf] += (v[0] * w[0] + v[1] * w[1]) + (v[2] * w[2] + v[3] * w[3]);
            }
        }
#pragma unroll
        for (int j = 0; j < 8; ++j) fl[j] = wave_sum(fl[j]);
        if (lane < 8) {
            float z = fl[0];
#pragma unroll
            for (int j = 1; j < 8; ++j) z = (lane == j) ? fl[j] : z;
            z += P.b_forget[lane];
            LOGF[(size_t)lane * M + m] = log_sigmoid_f(z);
        }
    }
    __syncthreads();
}

__device__ __forceinline__ void cumsum_phase(const Params& P, LAS unsigned char* lds, int wave, int lane) {
    const float* LOGF = (const float*)(P.ws + WS_LOGF); float* F = (float*)(P.ws + WS_F);
    LAS double* WT = (LAS double*)lds;
    for (int head = blockIdx.x; head < 8; head += gridDim.x) {
        const int t0 = threadIdx.x * 32;
        f32x4 lv[8];
#pragma unroll
        for (int i = 0; i < 8; ++i) lv[i] = *(const f32x4*)(LOGF + (size_t)head * M + t0 + 4 * i);
        double loc = 0.0;
#pragma unroll
        for (int i = 0; i < 8; ++i) loc += ((double)lv[i][0] + (double)lv[i][1]) + ((double)lv[i][2] + (double)lv[i][3]);
        double sc = loc;
#pragma unroll
        for (int o = 1; o < 64; o <<= 1) { const double n = __shfl_up(sc, o); if (lane >= o) sc += n; }
        if (lane == 63) WT[wave] = sc;
        __syncthreads();
        double base = sc - loc;
#pragma unroll
        for (int w = 0; w < NWAVES; ++w) base += (w < wave) ? WT[w] : 0.0;
        double run = base;
#pragma unroll
        for (int i = 0; i < 8; ++i) { f32x4 o;
#pragma unroll
            for (int e = 0; e < 4; ++e) { run += (double)lv[i][e]; o[e] = (float)run; }
            *(f32x4*)(F + (size_t)head * M + t0 + 4 * i) = o; }
        __syncthreads();
    }
}

__device__ __forceinline__ void ln_phase(float* T, const float* g, const float* b, const float* sh, const float* sc, bf16* H, LAS unsigned char* lds, int wave, int lane) {
    LAS float* G = (LAS float*)lds; LAS float* B = G + DM; LAS float* SC1 = B + DM; LAS float* SH = SC1 + DM;
    for (int i = threadIdx.x; i < DM; i += NTHR) { G[i] = g[i]; B[i] = b[i]; SC1[i] = sc ? 1.0f + sc[i] : 1.0f; SH[i] = sh ? sh[i] : 0.f; }
    __syncthreads();
    const int gw = blockIdx.x * NWAVES + wave, NGW = gridDim.x * NWAVES;
    for (int m = gw; m < M; m += NGW) {
        f32x4* xr = (f32x4*)(T + (size_t)m * DM) + lane;
        f32x4 v[8]; float s = 0.f;
#pragma unroll
        for (int j = 0; j < 8; ++j) { v[j] = xr[64 * j]; s += (v[j][0] + v[j][1]) + (v[j][2] + v[j][3]); }
        const float mean = wave_sum(s) * (1.f / DM); float s2 = 0.f;
#pragma unroll
        for (int j = 0; j < 8; ++j) { v[j] = v[j] - mean; s2 += (v[j][0] * v[j][0] + v[j][1] * v[j][1]) + (v[j][2] * v[j][2] + v[j][3] * v[j][3]); }
        const float rstd = 1.f / sqrtf(wave_sum(s2) * (1.f / DM) + LN_EPS);
#pragma unroll
        for (int j = 0; j < 8; ++j) {
            const f32x4 gg = *(const LAS f32x4*)(G + 4 * lane + 256 * j), bb = *(const LAS f32x4*)(B + 4 * lane + 256 * j);
            const f32x4 y = v[j] * rstd * gg + bb;
            xr[64 * j] = y;
            if (H) {
                const f32x4 s1 = *(const LAS f32x4*)(SC1 + 4 * lane + 256 * j), hh = *(const LAS f32x4*)(SH + 4 * lane + 256 * j);
                const f32x4 h = y * s1 + hh;
                ((unsigned long long*)(H + (size_t)m * DM) + lane)[64 * j] = (unsigned long long)pk2(h[0], h[1]) | ((unsigned long long)pk2(h[2], h[3]) << 32);
            }
        }
    }
    __syncthreads();
}

__device__ __forceinline__ void ln_apply_phase(const float* T, const float* stat, const float* g, const float* b, const float* sh, const float* sc, bf16* H, float* OUT,
                                               LAS unsigned char* lds, int wave, int lane) {
    LAS float* A = (LAS float*)lds; LAS float* B = A + DM;
    for (int i = threadIdx.x; i < DM; i += NTHR) { const float s1 = sc ? 1.0f + sc[i] : 1.0f; A[i] = g[i] * s1; B[i] = b[i] * s1 + (sh ? sh[i] : 0.f); }
    __syncthreads();
    const int gw = blockIdx.x * NWAVES + wave, NGW = gridDim.x * NWAVES;
    f32x4 av[8], bv[8];
#pragma unroll
    for (int j = 0; j < 8; ++j) { av[j] = *(const LAS f32x4*)(A + 4 * lane + 256 * j); bv[j] = *(const LAS f32x4*)(B + 4 * lane + 256 * j); }
#pragma unroll 2
    for (int m = gw; m < M; m += NGW) {
        const f32x4* xr = (const f32x4*)(T + (size_t)m * DM) + lane;
        f32x4 v[8];
#pragma unroll
        for (int j = 0; j < 8; ++j) v[j] = xr[64 * j];
        const float s1 = stat[2 * m], s2 = stat[2 * m + 1];
        const float mean = s1 * (1.0f / DM), var = s2 * (1.0f / DM) - mean * mean, rstd = 1.0f / sqrtf(var + LN_EPS);
#pragma unroll
        for (int j = 0; j < 8; ++j) {
            const f32x4 y = (v[j] - mean) * rstd * av[j] + bv[j];
            if (H) ((unsigned long long*)(H + (size_t)m * DM) + lane)[64 * j] = (unsigned long long)pk2(y[0], y[1]) | ((unsigned long long)pk2(y[2], y[3]) << 32);
            if (OUT) ((f32x4*)(OUT + (size_t)m * DM) + lane)[64 * j] = y;
        }
    }
    __syncthreads();
}

template <int D> struct AttnL { static constexpr int KP = D * 2 + 16, VP = 144, KBYTES = 64 * KP, VBYTES = D * VP, BIAS_OFF = KBYTES + VBYTES, BUF = BIAS_OFF + 256; };
__device__ __forceinline__ unsigned cvtpk(float lo, float hi) { unsigned r; asm volatile("v_cvt_pk_bf16_f32 %0, %1, %2" : "=v"(r) : "v"(lo), "v"(hi)); return r; }

#ifndef ATT_KDB
#define ATT_KDB 0
#endif
#ifndef ATT_VDB
#define ATT_VDB 0
#endif
template <int D, bool BIAS, bool NOMAX>
__device__ __forceinline__ void attn_tile(const LAS unsigned char* buf, const bf16x8 (&Qf)[D / 16], f32x16 (&o)[D / 32], float& m, float& l, float rowc, int dq, unsigned W, bool need_mask, int lane) {
    typedef AttnL<D> L;
    const int r32 = lane & 31, hh = lane >> 5;
    constexpr int GPB = (D / 16) / 4, NKG = 2 * GPB;
    constexpr int NDB = D / 32;
    f32x16 p[2];
    bf16x8 kf[2][4];
    const LAS unsigned char* kbase = buf + r32 * L::KP + 16 * hh;
#define AT_KLOAD(gi, dst) do { _Pragma("unroll") for (int j_ = 0; j_ < 4; ++j_) \
        dst[j_] = *(const LAS bf16x8*)(kbase + (32 * ((gi) / GPB)) * L::KP + (4 * ((gi) % GPB) + j_) * 32); } while (0)
#if ATT_KDB
    AT_KLOAD(0, kf[0]);
#endif
#pragma unroll
    for (int b = 0; b < 2; ++b) {
        if (BIAS) {
#pragma unroll
            for (int g = 0; g < 4; ++g) { const f32x4 bv = *(const LAS f32x4*)(buf + L::BIAS_OFF + (32 * b + 8 * g + 4 * hh) * 4);
                p[b][4 * g + 0] = bv[0]; p[b][4 * g + 1] = bv[1]; p[b][4 * g + 2] = bv[2]; p[b][4 * g + 3] = bv[3]; }
        } else {
#pragma unroll
            for (int r = 0; r < 16; ++r) p[b][r] = 0.f;
        }
    }
    __builtin_amdgcn_sched_barrier(0);
#pragma unroll
    for (int gi = 0; gi < NKG; ++gi) {
#if ATT_KDB
        if (gi + 1 < NKG) AT_KLOAD(gi + 1, kf[(gi + 1) & 1]);
#else
        AT_KLOAD(gi, kf[gi & 1]);
#endif
        __builtin_amdgcn_sched_barrier(0);
#pragma unroll
        for (int j = 0; j < 4; ++j) p[gi / GPB] = __builtin_amdgcn_mfma_f32_32x32x16_bf16(kf[gi & 1][j], Qf[4 * (gi % GPB) + j], p[gi / GPB], 0, 0, 0);
        __builtin_amdgcn_sched_barrier(0);
    }
#undef AT_KLOAD
    u32x4 vf[2][NDB];
    const LAS unsigned char* vbase = buf + L::KBYTES + r32 * L::VP + 8 * hh;
#define AT_VLOAD(gi, dst) do { _Pragma("unroll") for (int db_ = 0; db_ < NDB; ++db_) { \
        const LAS unsigned char* vp_ = vbase + (32 * db_) * L::VP + (gi) * 32; \
        const u32x2 lo_ = *(const LAS u32x2*)vp_, hi_ = *(const LAS u32x2*)(vp_ + 16); \
        dst[db_].x = lo_.x; dst[db_].y = lo_.y; dst[db_].z = hi_.x; dst[db_].w = hi_.y; } } while (0)
#if ATT_VDB
    AT_VLOAD(0, vf[0]);
#endif
    if (need_mask) {
        const float NEG = -__builtin_inff();
#pragma unroll
        for (int b = 0; b < 2; ++b)
#pragma unroll
            for (int r = 0; r < 16; ++r) { const int krel = 32 * b + (r & 3) + 8 * (r >> 2); if ((unsigned)(dq - krel) >= W) p[b][r] = NEG; }
    }
    if (NOMAX) {
        float rs = 0.f;
#pragma unroll
        for (int b = 0; b < 2; ++b)
#pragma unroll
            for (int r = 0; r < 16; ++r) { p[b][r] = __builtin_amdgcn_exp2f(p[b][r] + rowc); rs += p[b][r]; }
        l += rs;
    } else {
    float mx = p[0][0];
#pragma unroll
    for (int r = 1; r < 16; ++r) mx = fmaxf(mx, p[0][r]);
#pragma unroll
    for (int r = 0; r < 16; ++r) mx = fmaxf(mx, p[1][r]);
    mx = fmaxf(mx, __shfl_xor(mx, 32));
    const float mn = fmaxf(m, mx);
    const float alpha = __builtin_amdgcn_exp2f(m - mn);
    m = mn;
    float rs = 0.f;
#pragma unroll
    for (int b = 0; b < 2; ++b)
#pragma unroll
        for (int r = 0; r < 16; ++r) { p[b][r] = __builtin_amdgcn_exp2f(p[b][r] - mn); rs += p[b][r]; }
    l = l * alpha + rs;
#pragma unroll
    for (int db = 0; db < NDB; ++db) o[db] = o[db] * alpha;
    }
    __builtin_amdgcn_sched_barrier(0);
#pragma unroll
    for (int gi = 0; gi < 4; ++gi) {
        const int b = gi >> 1, sx = gi & 1;
#if ATT_VDB
        if (gi + 1 < 4) AT_VLOAD(gi + 1, vf[(gi + 1) & 1]);
#else
        AT_VLOAD(gi, vf[gi & 1]);
#endif
        u32x4 pw; pw.x = cvtpk(p[b][8 * sx + 0], p[b][8 * sx + 1]); pw.y = cvtpk(p[b][8 * sx + 2], p[b][8 * sx + 3]); pw.z = cvtpk(p[b][8 * sx + 4], p[b][8 * sx + 5]); pw.w = cvtpk(p[b][8 * sx + 6], p[b][8 * sx + 7]);
        const bf16x8 pf = __builtin_bit_cast(bf16x8, pw);
        __builtin_amdgcn_sched_barrier(0);
#pragma unroll
        for (int db = 0; db < NDB; ++db) o[db] = __builtin_amdgcn_mfma_f32_32x32x16_bf16(__builtin_bit_cast(bf16x8, vf[gi & 1][db]), pf, o[db], 0, 0, 0);
        __builtin_amdgcn_sched_barrier(0);
    }
#undef AT_VLOAD
}

template <int D, bool BIAS, bool NOMAX, bool GQA = false>
__device__ __forceinline__ void attn_unit(LAS unsigned char* lds, const bf16* Qp, int ldq, const bf16* Kp, int ldk, const bf16* Vt, const float* Fh, bf16* Op, int ldo,
                                          int q0, int t_lo, int t_hi, unsigned W, float m_init, float l_init, float cbound, int wave, int lane) {
    typedef AttnL<D> L;
    constexpr int KCH = D / 64;
    const int tid = threadIdx.x, r32 = lane & 31, hh = lane >> 5;
    const int qrow0 = GQA ? q0 : q0 + 32 * wave;
    if (GQA) { Qp += wave * D; Op += wave * D; }
    bf16x8 Qf[D / 16];
#pragma unroll
    for (int ks = 0; ks < D / 16; ++ks) Qf[ks] = *(const bf16x8*)(Qp + (size_t)(qrow0 + r32) * ldq + 16 * ks + 8 * hh);
    f32x16 o[D / 32];
#pragma unroll
    for (int db = 0; db < D / 32; ++db)
#pragma unroll
        for (int r = 0; r < 16; ++r) o[db][r] = 0.f;
    float m = m_init, l = (hh == 0) ? l_init : 0.f;
    float rowc = 0.f;
    if (NOMAX) rowc = Fh[qrow0 + r32] * LOG2E - cbound;
    u32x4 kreg[KCH], vreg[KCH]; float breg = 0.f;
#define ATT_LOAD(t) do { const int kb_ = (t) * 64; \
        _Pragma("unroll") for (int i_ = 0; i_ < KCH; ++i_) { const int c_ = tid + 512 * i_; \
            { const int key_ = c_ / (D / 8), cc_ = c_ % (D / 8); kreg[i_] = *(const u32x4*)(Kp + (size_t)(kb_ + key_) * ldk + 8 * cc_); } \
            { const int d_ = c_ >> 3, kc_ = c_ & 7; vreg[i_] = *(const u32x4*)(Vt + (size_t)d_ * M + kb_ + 8 * kc_); } } \
        if (BIAS) { if (tid < 64) breg = Fh[kb_ + tid] * (-LOG2E); } } while (0)
#define ATT_STORE(bufp) do { \
        _Pragma("unroll") for (int i_ = 0; i_ < KCH; ++i_) { const int c_ = tid + 512 * i_; \
            { const int key_ = c_ / (D / 8), cc_ = c_ % (D / 8); *(LAS u32x4*)((bufp) + key_ * L::KP + cc_ * 16) = kreg[i_]; } \
            { const int d_ = c_ >> 3, kc_ = c_ & 7; *(LAS u32x4*)((bufp) + L::KBYTES + d_ * L::VP + kc_ * 16) = vreg[i_]; } } \
        if (BIAS) { if (tid < 64) *(LAS float*)((bufp) + L::BIAS_OFF + tid * 4) = breg; } } while (0)
    ATT_LOAD(t_lo);
    ATT_STORE(lds);
    __syncthreads();
    for (int t = t_lo; t < t_hi; ++t) {
        LAS unsigned char* cur = lds + ((t - t_lo) & 1) * L::BUF;
        LAS unsigned char* nxt = lds + (((t - t_lo) & 1) ^ 1) * L::BUF;
        if (t + 1 < t_hi) ATT_LOAD(t + 1);
        const int kb = t * 64;
        const long long lo_need = (long long)qrow0 - (long long)(W - 1u);
        const bool active = (kb <= qrow0 + 31) && ((long long)kb + 63 >= lo_need);
        if (active) {
            const bool full = (kb + 63 <= qrow0) && ((long long)kb >= (long long)qrow0 + 31 - (long long)(W - 1u));
            attn_tile<D, BIAS, NOMAX>(cur, Qf, o, m, l, rowc, (qrow0 + r32) - kb - 4 * hh, W, !full, lane);
        }
        if (t + 1 < t_hi) ATT_STORE(nxt);
        __syncthreads();
    }
#undef ATT_LOAD
#undef ATT_STORE
    const float lt = l + __shfl_xor(l, 32);
    const float inv = 1.0f / lt;
    bf16* orow = Op + (size_t)(qrow0 + r32) * ldo;
#pragma unroll
    for (int db = 0; db < D / 32; ++db)
#pragma unroll
        for (int g = 0; g < 4; ++g) {
            u32x2 w; w.x = cvtpk(o[db][4 * g + 0] * inv, o[db][4 * g + 1] * inv); w.y = cvtpk(o[db][4 * g + 2] * inv, o[db][4 * g + 3] * inv);
            *(u32x2*)(orow + 32 * db + 8 * g + 4 * hh) = w;
        }
}

__device__ __forceinline__ void fox_norm_phase(const Params& P, int wave, int lane) {
    const bf16* Q = (const bf16*)(P.ws + WS_Q); const bf16* K = (const bf16*)(P.ws + WS_K);
    unsigned* ctl = (unsigned*)(P.ws + WS_MOD);
    const int gw = blockIdx.x * NWAVES + wave, NGW = gridDim.x * NWAVES;
    for (int it = gw; it < 2 * 8 * 256; it += NGW) {
        const int isk = it & 1, head = (it >> 1) & 7, tile = it >> 4;
        const bf16* src = (isk ? K : Q) + (size_t)tile * 64 * FW + head * 128;
        float mx = 0.f;
#pragma unroll 4
        for (int i = 0; i < 16; ++i) {
            const u32x4 w = *(const u32x4*)(src + (size_t)(4 * i + (lane >> 4)) * FW + 8 * (lane & 15));
            float a = bflo(w.x) * bflo(w.x) + bfhi(w.x) * bfhi(w.x); a += bflo(w.y) * bflo(w.y) + bfhi(w.y) * bfhi(w.y);
            a += bflo(w.z) * bflo(w.z) + bfhi(w.z) * bfhi(w.z); a += bflo(w.w) * bflo(w.w) + bfhi(w.w) * bfhi(w.w);
            a += __shfl_xor(a, 1); a += __shfl_xor(a, 2); a += __shfl_xor(a, 4); a += __shfl_xor(a, 8);
            mx = fmaxf(mx, a);
        }
        mx = fmaxf(mx, __shfl_xor(mx, 16)); mx = fmaxf(mx, __shfl_xor(mx, 32));
        if (lane == 0) atomicMax(ctl + (isk ? CW_KMAX2 + head : CW_QN2 + head * 64 + (tile >> 2)), __float_as_uint(mx));
    }
}
__device__ __forceinline__ void fox_phase(const Params& P, LAS unsigned char* lds, int wave, int lane) {
    const bf16* Q = (const bf16*)(P.ws + WS_Q); const bf16* K = (const bf16*)(P.ws + WS_K); const bf16* VT = (const bf16*)(P.ws + WS_VT);
    const float* F = (const float*)(P.ws + WS_F); bf16* MIX = (bf16*)(P.ws + WS_MIX);
    const unsigned* ctl = (const unsigned*)(P.ws + WS_MOD);
    for (int it = (int)VCU(lds); it < 256; it += gridDim.x) {
        const int head = it & 7, pi = it >> 3;
#pragma unroll 1
        for (int half = 0; half < 2; ++half) {
            const int qb = half == 0 ? 63 - pi : pi;
            const float* Fh = F + (size_t)head * M;
            const float kn = sqrtf(__uint_as_float(ctl[CW_KMAX2 + head])), qn = sqrtf(__uint_as_float(ctl[CW_QN2 + head * 64 + qb]));
            const float bound = 2.0f * qn * kn * 1.01f + 2.0f;
            const int j = threadIdx.x;
            const bool skippable = (j < 4 * qb) && (bound + (Fh[qb * 256] - Fh[j < 256 ? 64 * j + 63 : 63]) * LOG2E < -152.0f);
            const int t_lo = __syncthreads_count(skippable ? 1 : 0);
            attn_unit<128, true, true>(lds, Q + head * 128, FW, K + head * 128, FW, VT + (size_t)head * 128 * M, Fh, MIX + head * 128, DM,
                                       qb * 256, t_lo, 4 * qb + 4, 0x7fffffffu, -1e30f, 0.f, fminf(0.5f * bound, 55.0f), wave, lane);
        }
    }
}

__device__ __forceinline__ void swa_phase(const Params& P, LAS unsigned char* lds, int wave, int lane) {
    const bf16* Q = (const bf16*)(P.ws + WS_Q2); const bf16* K = (const bf16*)(P.ws + WS_K2); const bf16* VT = (const bf16*)(P.ws + WS_VT2); bf16* O = (bf16*)(P.ws + WS_MIX);
    for (int it = (int)VCU(lds); it < 2048; it += gridDim.x) {
        const int kv = (it & 7) >> 1, rb = ((it & 1) << 8) | (it >> 3);
        const int q0 = rb * 32;
        const float sinkl = P.sinks[kv * 8 + wave] * LOG2E;
        const int t_lo = (q0 - 127) < 0 ? 0 : ((q0 - 127) >> 6), t_hi = (q0 >> 6) + 1;
        attn_unit<64, false, false, true>(lds, Q + kv * 512, DM, K + kv * 64, KVW, VT + (size_t)kv * 64 * M, nullptr, O + kv * 512, DM, q0, t_lo, t_hi, 128u, sinkl, 1.0f, 0.f, wave, lane);
    }
}

constexpr int SSM_SUB = 256, SSM_NSUB = M / SSM_SUB  , SSM_STEPS = SSM_SUB / 16;
struct SsmC2 { f32x2 lb[2]; f32x2 lbR[2]; bf16x8 Bh[4], Bl[4]; };
__device__ __forceinline__ void ssm_consts2(const Params& P, int g, int lane, SsmC2& C) {
    const int p5 = lane & 31, hh = lane >> 5;
    const double dtf = exp((double)P.log_dt[g]);
#pragma unroll
    for (int par = 0; par < 2; ++par) {
        const int st = 2 * p5 + par;
        const double lr = (double)P.lam_re[g * 64 + st], li = (double)P.lam_im[g * 64 + st];
        const double mag = exp(lr * dtf);
        double s, c; sincos_d(li * dtf, s, c);
        const double lbr = mag * c, lbi = mag * s;
        const double den = lr * lr + li * li, nr = lbr - 1.0;
        const double qr = (nr * lr + lbi * li) / den, qi = (lbi * lr - nr * li) / den;
        C.lb[par] = (f32x2){(float)lbr, (float)lbi};
        const double magR = exp(lr * dtf * SSM_SUB);
        double sR, cR; sincos_d(li * dtf * SSM_SUB, sR, cR);
        C.lbR[par] = (f32x2){(float)(magR * cR), (float)(magR * sR)};
        const f32x4* br = (const f32x4*)(P.b_re + (size_t)(g * 64 + st) * 16 + 8 * hh); const f32x4* bi = (const f32x4*)(P.b_im + (size_t)(g * 64 + st) * 16 + 8 * hh);
        float vre[8], vim[8];
#pragma unroll
        for (int j = 0; j < 2; ++j) { const f32x4 r = br[j], i = bi[j];
#pragma unroll
            for (int e = 0; e < 4; ++e) { const double rr = (double)r[e], ii = (double)i[e]; vre[4 * j + e] = (float)(qr * rr - qi * ii); vim[4 * j + e] = (float)(qr * ii + qi * rr); } }
        u32x4 hr, lr4, hi4, li4;
#pragma unroll
        for (int e = 0; e < 4; ++e) {
            const unsigned wr = cvtpk(vre[2 * e], vre[2 * e + 1]); hr[e] = wr; lr4[e] = cvtpk(vre[2 * e] - bflo(wr), vre[2 * e + 1] - bfhi(wr));
            const unsigned wi = cvtpk(vim[2 * e], vim[2 * e + 1]); hi4[e] = wi; li4[e] = cvtpk(vim[2 * e] - bflo(wi), vim[2 * e + 1] - bfhi(wi));
        }
        C.Bh[par] = __builtin_bit_cast(bf16x8, hr); C.Bl[par] = __builtin_bit_cast(bf16x8, lr4);
        C.Bh[2 + par] = __builtin_bit_cast(bf16x8, hi4); C.Bl[2 + par] = __builtin_bit_cast(bf16x8, li4);
    }
}
__device__ __forceinline__ void ssm_bu(const SsmC2& C, const bf16x8 ua, f32x16 (&acc)[4]) {
#pragma unroll
    for (int b = 0; b < 4; ++b) {
#pragma unroll
        for (int r = 0; r < 16; ++r) acc[b][r] = 0.f;
        acc[b] = __builtin_amdgcn_mfma_f32_32x32x16_bf16(ua, C.Bh[b], acc[b], 0, 0, 0);
        acc[b] = __builtin_amdgcn_mfma_f32_32x32x16_bf16(ua, C.Bl[b], acc[b], 0, 0, 0);
    }
}
__device__ __forceinline__ void ssm_upd(const f32x2 lb, f32x2& x, float bre, float bim) {
    const f32x2 nx = {__builtin_fmaf(lb.x, x.x, __builtin_fmaf(-lb.y, x.y, bre)), __builtin_fmaf(lb.x, x.y, __builtin_fmaf(lb.y, x.x, bim))};
    x = nx;
}
__device__ __forceinline__ void ssm_pass1(const Params& P, LAS unsigned char* lds, int wave, int lane) {
    const bf16* U = (const bf16*)(P.ws + WS_U); f32x4* E = (f32x4*)(P.ws + WS_E);
    const int gw = __builtin_amdgcn_readfirstlane(blockIdx.x * NWAVES + wave), NGW = gridDim.x * NWAVES;
    const int p5 = lane & 31, hh = lane >> 5;
    const int asr = (p5 >> 2) & 1, ajj = (p5 & 3) + 4 * (p5 >> 3);
    for (int it = gw; it < 64 * (SSM_NSUB / 2); it += NGW) {
        const int g = it & 63, run = it >> 6;
        const bf16* up = U + ((size_t)(run * 2 + asr) * SSM_SUB + 8 * ajj) * FW + g * 16 + 8 * hh;
        bf16x8 ua[8];
#pragma unroll
        for (int ks = 0; ks < 8; ++ks) ua[ks] = *(const bf16x8*)(up + (size_t)ks * FW);
        const double dtf = exp((double)P.log_dt[g]);
        f32x2 xe[2] = {{0.f, 0.f}, {0.f, 0.f}};
#pragma unroll
        for (int par = 0; par < 2; ++par) {
            const int st = 2 * p5 + par;
            const double lr = (double)P.lam_re[g * 64 + st], li = (double)P.lam_im[g * 64 + st];
            const double mag = exp(lr * dtf);
            double s, c; sincos_d(li * dtf, s, c);
            const double lbr = mag * c, lbi = mag * s;
            const double den = lr * lr + li * li, nr = lbr - 1.0;
            const double qr = (nr * lr + lbi * li) / den, qi = (lbi * lr - nr * li) / den;
            const f32x4* br = (const f32x4*)(P.b_re + (size_t)(g * 64 + st) * 16 + 8 * hh); const f32x4* bi = (const f32x4*)(P.b_im + (size_t)(g * 64 + st) * 16 + 8 * hh);
            float vre[8], vim[8];
#pragma unroll
            for (int j = 0; j < 2; ++j) { const f32x4 r = br[j], i = bi[j];
#pragma unroll
                for (int e = 0; e < 4; ++e) { const double rr = (double)r[e], ii = (double)i[e]; vre[4 * j + e] = (float)(qr * rr - qi * ii); vim[4 * j + e] = (float)(qr * ii + qi * rr); } }
            const float lx = (float)lbr, ly = (float)lbi;
            float wx = 1.f, wy = 0.f;
            bf16x8 Wre[8], Wim[8];
#pragma unroll
            for (int ks = 7; ks >= 0; --ks) {
                u32x4 fr4, fi4;
#pragma unroll
                for (int e = 0; e < 4; ++e) {
                    fr4[e] = cvtpk(wx * vre[2 * e] - wy * vim[2 * e], wx * vre[2 * e + 1] - wy * vim[2 * e + 1]);
                    fi4[e] = cvtpk(wx * vim[2 * e] + wy * vre[2 * e], wx * vim[2 * e + 1] + wy * vre[2 * e + 1]);
                }
                Wre[ks] = __builtin_bit_cast(bf16x8, fr4); Wim[ks] = __builtin_bit_cast(bf16x8, fi4);
                const float nx = wx * lx - wy * ly, ny = wx * ly + wy * lx; wx = nx; wy = ny;
            }
            const f32x2 l8 = {wx, wy};
#pragma unroll
            for (int c2 = 0; c2 < 2; ++c2) {
                if (!(par == 0 && c2 == 0)) {
#pragma unroll
                    for (int ks = 0; ks < 8; ++ks) ua[ks] = *(const bf16x8*)(up + (size_t)(c2 * 128 + ks) * FW);
                }
                f32x16 are, aim;
#pragma unroll
                for (int r = 0; r < 16; ++r) { are[r] = 0.f; aim[r] = 0.f; }
#pragma unroll
                for (int ks = 0; ks < 8; ++ks) { are = __builtin_amdgcn_mfma_f32_32x32x16_bf16(ua[ks], Wre[ks], are, 0, 0, 0); aim = __builtin_amdgcn_mfma_f32_32x32x16_bf16(ua[ks], Wim[ks], aim, 0, 0, 0); }
#pragma unroll
                for (int r = 0; r < 16; ++r) ssm_upd(l8, xe[par], are[r], aim[r]);
            }
        }
        E[((size_t)(run * 2 + hh) * 64 + g) * 32 + p5] = (f32x4){xe[0].x, xe[0].y, xe[1].x, xe[1].y};
    }
}
__device__ __forceinline__ float sigmoid_f(float v) { return __builtin_amdgcn_rcpf(1.0f + __builtin_amdgcn_exp2f(-1.4426950408889634f * v)); }
__device__ __forceinline__ float gelu_tanh_f(float y) { const float z = 0.7978845608028654f * (y + 0.044715f * y * y * y); return y * sigmoid_f(2.0f * z); }
__device__ __forceinline__ void ssm_pass2(const Params& P, LAS unsigned char* lds, int wave, int lane) {
    const bf16* U = (const bf16*)(P.ws + WS_U); const f32x4* E = (const f32x4*)(P.ws + WS_E); bf16* S = (bf16*)(P.ws + WS_S);
    LAS unsigned char* XL = lds + wave * 8192;
    const int gw = __builtin_amdgcn_readfirstlane(blockIdx.x * NWAVES + wave), NGW = gridDim.x * NWAVES;
    const int p5 = lane & 31, hh = lane >> 5;
    const int ahh = (p5 >> 2) & 1, ar = (p5 & 3) + 4 * (p5 >> 3);
    const int h = lane & 15, tq = lane >> 4;
    for (int it = gw; it < 64 * (SSM_NSUB / 2); it += NGW) {
        const int g = it & 63, run = it >> 6;
        SsmC2 C; ssm_consts2(P, g, lane, C);
        const bf16* up = U + ((size_t)(run * 2 + ahh) * SSM_SUB + ar) * FW + g * 16 + 8 * hh;
        bf16x8 u0 = *(const bf16x8*)up, u1 = *(const bf16x8*)(up + (size_t)16 * FW), u2 = *(const bf16x8*)(up + (size_t)32 * FW), u3 = *(const bf16x8*)(up + (size_t)48 * FW);
        bf16x8 Cf[4];
#pragma unroll
        for (int ks = 0; ks < 4; ++ks) {
            const f32x4 cr = *(const f32x4*)(P.c_re + (size_t)(g * 16 + h) * 64 + 16 * ks + 4 * tq), ci = *(const f32x4*)(P.c_im + (size_t)(g * 16 + h) * 64 + 16 * ks + 4 * tq);
            u32x4 w; w.x = cvtpk(cr[0], -ci[0]); w.y = cvtpk(cr[1], -ci[1]); w.z = cvtpk(cr[2], -ci[2]); w.w = cvtpk(cr[3], -ci[3]);
            Cf[ks] = __builtin_bit_cast(bf16x8, w);
        }
        const float dsk = P.ssm_d[g * 16 + h];
        f32x2 x0 = {0.f, 0.f}, x1 = {0.f, 0.f};
        const int sr = 2 * run + hh;
#pragma unroll 8
        for (int rr = 0; rr < 2 * run + 1; ++rr) {
            const f32x4 e = E[((size_t)rr * 64 + g) * 32 + p5];
            if (rr < sr) { ssm_upd(C.lbR[0], x0, e[0], e[1]); ssm_upd(C.lbR[1], x1, e[2], e[3]); }
        }
        LAS unsigned char* wbase = XL + hh * 16 * 256 + (p5 & 1) * 8;
#pragma unroll 1
        for (int step = 0; step < SSM_STEPS; ++step) {
            const bf16x8 ua = u0; u0 = u1; u1 = u2; u2 = u3;
            if (step + 4 < SSM_STEPS) u3 = *(const bf16x8*)(up + (size_t)(step + 4) * 16 * FW);
            f32x16 acc[4]; ssm_bu(C, ua, acc);
#pragma unroll
            for (int r = 0; r < 16; ++r) {
                ssm_upd(C.lb[0], x0, acc[0][r], acc[2][r]); ssm_upd(C.lb[1], x1, acc[1][r], acc[3][r]);
                u32x2 w; w.x = cvtpk(x0.x, x0.y); w.y = cvtpk(x1.x, x1.y);
                *(LAS u32x2*)(wbase + r * 256 + (((p5 >> 1) ^ r) << 4)) = w;
            }
            asm volatile("s_waitcnt lgkmcnt(0)" ::: "memory");
#pragma unroll
            for (int rb = 0; rb < 2; ++rb) {
                f32x4 ya = {0.f, 0.f, 0.f, 0.f};
#pragma unroll
                for (int ks = 0; ks < 4; ++ks) {
                    const bf16x8 af = *(const LAS bf16x8*)(XL + (16 * rb + h) * 256 + (((4 * ks + tq) ^ h) << 4));
                    ya = __builtin_amdgcn_mfma_f32_16x16x32_bf16(af, Cf[ks], ya, 0, 0, 0);
                }
#pragma unroll
                for (int q = 0; q < 4; ++q) {
                    const size_t tok = (size_t)(run * 2 + rb) * SSM_SUB + step * 16 + 4 * tq + q;
                    const float uv = __builtin_bit_cast(float, (unsigned)U[tok * FW + g * 16 + h] << 16);
                    S[tok * FW + g * 16 + h] = (bf16)f2bf(gelu_tanh_f(ya[q] + dsk * uv));
                }
            }
            asm volatile("s_waitcnt lgkmcnt(0)" ::: "memory");
        }
    }
}
#define XB_TMO      128
#define XB_XCNT(j)  (256  + 64 * (j))
#define XB_XSUB(j)  (1280 + 64 * (j))
#define XB_XGEN(j)  (2304 + 64 * (j))
#define XB_TOP      3328
#define XB_TOPGEN   3392
#define XCD_BAR_WORDS 3456
#define XB_SPIN_CAP (1u << 23)

__device__ __forceinline__ unsigned xb_ld(unsigned* p)              { return __hip_atomic_load(p, __ATOMIC_RELAXED, __HIP_MEMORY_SCOPE_AGENT); }
__device__ __forceinline__ unsigned xb_add(unsigned* p, unsigned v) { return __hip_atomic_fetch_add(p, v, __ATOMIC_RELAXED, __HIP_MEMORY_SCOPE_AGENT); }
__device__ __forceinline__ unsigned xb_xcc_id() { return (unsigned)__builtin_amdgcn_s_getreg((3 << 11) | 20) & 0xFu; }
#define XB_SPIN(cond, bar) do { unsigned _sp = 0; while (cond) { __builtin_amdgcn_s_sleep(1); \
    if ((++_sp & 255u) == 0u) { if (xb_ld(&(bar)[XB_TMO])) break; if (_sp > XB_SPIN_CAP) { atomicAdd(&(bar)[XB_TMO], 1u); break; } } } } while (0)

struct XcdBarrier {
    unsigned* bar; unsigned x;
    volatile LAS unsigned* st;
};

__device__ __forceinline__ XcdBarrier xcd_barrier_post(unsigned* bar, volatile LAS unsigned* st) {
    XcdBarrier b; b.bar = bar; b.x = xb_xcc_id(); b.st = st;
    if (threadIdx.x == 0) st[3] = xb_add(&bar[XB_XCNT(b.x)], 1u);
    return b;
}
__device__ __forceinline__ void xcd_barrier_complete(unsigned* bar, unsigned x, unsigned& nloc, unsigned& nx) {
    const unsigned G = gridDim.x * gridDim.y * gridDim.z;
    unsigned sum, cnt, mine, sp = 0u;
    for (;;) {
        sum = 0u; cnt = 0u; mine = 0u;
#pragma unroll
        for (unsigned j = 0; j < 16; ++j) { const unsigned c = xb_ld(&bar[XB_XCNT(j)]); sum += c; cnt += (c > 0u) ? 1u : 0u; mine = (j == x) ? c : mine; }
        if (sum == G) break;
        __builtin_amdgcn_s_sleep(1);
        if ((++sp & 255u) == 0u) { if (xb_ld(&bar[XB_TMO])) break; if (sp > XB_SPIN_CAP) { atomicAdd(&bar[XB_TMO], 1u); break; } }
    }
    nloc = mine > 0u ? mine : 1u; nx = cnt > 0u ? cnt : 1u;
}

__device__ __forceinline__ void xcd_barrier(const XcdBarrier& b) {
    asm volatile("s_waitcnt vmcnt(0)" ::: "memory");
    __syncthreads();
    if (threadIdx.x == 0) {
        unsigned* bar = b.bar;
        __builtin_amdgcn_s_waitcnt(0);
        unsigned nloc = b.st[0], nx = b.st[1];
        if (nloc == 0u) { xcd_barrier_complete(bar, b.x, nloc, nx); b.st[0] = nloc; b.st[1] = nx; }
        const unsigned old = xb_add(&bar[XB_XSUB(b.x)], 1u);
        const unsigned gen = old / nloc;
        if (old + 1u == (gen + 1u) * nloc) {
            __builtin_amdgcn_fence(__ATOMIC_RELEASE, "agent");
            asm volatile("s_waitcnt vmcnt(0)" ::: "memory");
            const unsigned og = xb_add(&bar[XB_TOP], 1u);
            const unsigned tg = og / nx;
            if (og + 1u == (tg + 1u) * nx) xb_add(&bar[XB_TOPGEN], 1u);
            else XB_SPIN(xb_ld(&bar[XB_TOPGEN]) == tg, bar);
            __builtin_amdgcn_fence(__ATOMIC_ACQUIRE, "agent");
            xb_add(&bar[XB_XGEN(b.x)], 1u);
            asm volatile("s_waitcnt vmcnt(0)" ::: "memory");
        } else {
            XB_SPIN(xb_ld(&bar[XB_XGEN(b.x)]) == gen, bar);
            __builtin_amdgcn_fence(__ATOMIC_ACQUIRE, "agent");
            asm volatile("s_waitcnt vmcnt(0)" ::: "memory");
        }
    }
    __syncthreads();
}

__device__ __forceinline__ int opaque_lane(int lane) { asm volatile("" : "+v"(lane)); return lane; }
constexpr int CW_BAR = 28672;
#ifdef PROBE_SYNC2
#define GSYNC() do { xcd_barrier(bar); xcd_barrier(bar); } while (0)
#else
#define GSYNC() xcd_barrier(bar)
#endif
#ifndef PG8_SP2
#define PG8_SP2 true
#endif
#ifndef PG8_ALIGN
#define PG8_ALIGN true
#endif
template <class Epi>
__device__ __forceinline__ void run_gemm(LAS unsigned char* lds, const bf16* A, const bf16* Bt, int m, int n, int k, const Epi& E, int cshift) {
    pg8::Gemm g{A, Bt, m, n, k}; pg8::StaticOrder S; S.init(m, n, (int)gridDim.x, (int)((VCU(lds) + cshift) % gridDim.x));
    pg8::gemm_phase<Epi, pg8::StaticOrder, PG8_ALIGN, PG8_SP2>(lds, g, S, E);
}

template <class Epi>
__device__ __forceinline__ void run_gemm_panel(LAS unsigned char* lds, const bf16* A, const bf16* Bt, int k, const Epi& E) {
    pg8::Gemm g{A, Bt, M, DM, k}; pg8::PanelOrder S; S.init((int)VCU(lds));
    pg8::gemm_phase<Epi, pg8::PanelOrder, PG8_ALIGN, PG8_SP2>(lds, g, S, E);
}
__device__ __forceinline__ void ffn_part(const Params& P, const int layer, LAS unsigned char* lds, const XcdBarrier& bar, int wave, int lane) {
    unsigned char* ws = P.ws;
    const float* mod = (const float*)(ws + WS_MOD);
    const float* md = mod + layer * 12288;
    bf16* H = (bf16*)(ws + WS_H); bf16* MID = (bf16*)(ws + WS_MID); float* XA = P.out;
    float* STAT = (float*)(ws + WS_STAT); unsigned* PCNT = (unsigned*)(ws + WS_PCNT);
    const float* st_mix = STAT + (size_t)(2 * layer) * 2 * M; float* st_ffn = STAT + (size_t)(2 * layer + 1) * 2 * M;
    {
        pg8::EpiSwiglu E{MID, DFF};
        run_gemm(lds, H, (const bf16*)(ws + (layer == 0 ? WS_WGU0 : WS_WGU1)), M, 2 * DFF, DM, E, 0);
#ifdef PROBE_GU2
        if (layer == 0) run_gemm(lds, H, (const bf16*)(ws + (layer == 0 ? WS_WGU0 : WS_WGU1)), M, 2 * DFF, DM, E, 0);
#endif
    }
    GSYNC();
    if (layer == 0) {
        pg8::EpiResidLNF<true, false> E{XA, XA, md + 5 * DM, ALPHA, DM, st_mix, P.ln_mix_g, P.ln_mix_b, st_ffn, PCNT + 1 * 4096, P.ln_ffn_g, P.ln_ffn_b, mod + 12288, mod + 12288 + DM, H, nullptr};
        run_gemm_panel(lds, MID, (const bf16*)(ws + WS_WD0), DFF, E);
    } else {
        pg8::EpiResidLNF<true, true> E{XA, XA, md + 5 * DM, ALPHA, DM, st_mix, P.ln_mix_g + DM, P.ln_mix_b + DM, st_ffn, PCNT + 3 * 4096, P.ln_ffn_g + DM, P.ln_ffn_b + DM, nullptr, nullptr, nullptr, XA};
        run_gemm_panel(lds, MID, (const bf16*)(ws + WS_WD1), DFF, E);
    }
}

__global__ void __launch_bounds__(NTHR, 2) mega_fwd(Params P) {
    extern __shared__ __attribute__((aligned(16))) unsigned char lds_raw[];
    cg::grid_group grid = cg::this_grid();
    LAS unsigned char* lds = (LAS unsigned char*)lds_raw;
    const int tid = threadIdx.x, lane = tid & 63, wave = __builtin_amdgcn_readfirstlane(tid >> 6);
    unsigned char* ws = P.ws;
    const float* mod = (const float*)(ws + WS_MOD);
    bf16* H = (bf16*)(ws + WS_H); bf16* MIX = (bf16*)(ws + WS_MIX); bf16* MID = (bf16*)(ws + WS_MID);
    float* XA = P.out;

    if (tid < 4) ((LAS unsigned*)(lds + LDS_BARST))[tid] = 0u;
    __syncthreads();
    const XcdBarrier bar = xcd_barrier_post((unsigned*)(ws + WS_MOD) + CW_BAR, (volatile LAS unsigned*)(lds + LDS_BARST));
#ifndef SK_P0
    p0_prologue(P, lds, wave, opaque_lane(lane));
#endif
    GSYNC();
    if (P.out == nullptr) grid.sync();
    if (tid == 0) {
        volatile LAS unsigned* st = (volatile LAS unsigned*)(lds + LDS_BARST);
        const unsigned rank = st[3], xcc = bar.x; unsigned v = 0;
#pragma unroll
        for (unsigned j = 0; j < 16; ++j) { const unsigned c = xb_ld(&bar.bar[XB_XCNT(j)]); v += (c < rank ? c : rank) + ((j < xcc && c > rank) ? 1u : 0u); }
#ifdef NO_VCU
        v = blockIdx.x;
#endif
        st[2] = v;
    }
    __syncthreads();
#ifndef SK_HPREP
    hprep_phase(P, lds, wave, opaque_lane(lane));
#if defined(PROBE_MISC2) || defined(PROBE_HPREP2)
    hprep_phase(P, lds, wave, opaque_lane(lane));
#endif
#endif
    GSYNC();

#ifndef SK_CUMSUM
    cumsum_phase(P, lds, wave, opaque_lane(lane));
#endif
    {
        pg8::EpiBf16<0> E{(bf16*)(ws + WS_Q), FW, nullptr, FW, (size_t)M * FW, 0.08838834764831845f * LOG2E};
        run_gemm(lds, H, (const bf16*)(ws + WS_W1T), M, 3 * FW, DM, E, 0);
    }
    {
        pg8::EpiBf16<0> E{(bf16*)(ws + WS_VT), M, nullptr, 0, 0, 1.0f};
        run_gemm(lds, (const bf16*)(ws + WS_WVT), H, FW, M, DM, E, 0);
    }
    GSYNC();
    fox_norm_phase(P, wave, opaque_lane(lane));
#ifndef SK_SSM1
    ssm_pass1(P, lds, wave, opaque_lane(lane));
#endif
#if defined(PROBE_MISC2) || defined(PROBE_P3A2)
    fox_norm_phase(P, wave, opaque_lane(lane)); ssm_pass1(P, lds, wave, opaque_lane(lane));
#endif
#ifdef PROBE_SSM1ONLY
    ssm_pass1(P, lds, wave, opaque_lane(lane));
#endif
#ifdef PROBE_CONSTS
    ssm_probe_consts(P, wave, opaque_lane(lane));
#endif
#ifdef PROBE_NORM2
    fox_norm_phase(P, wave, opaque_lane(lane));
#endif
    GSYNC();
#ifndef SK_FOX
    fox_phase(P, lds, wave, opaque_lane(lane));
#ifdef PROBE_FOX2
    __syncthreads(); fox_phase(P, lds, wave, opaque_lane(lane));
#endif
#endif
    __syncthreads();
#ifndef SK_SSM2
    ssm_pass2(P, lds, wave, opaque_lane(lane));
#ifdef PROBE_SSM2
    ssm_pass1(P, lds, wave, opaque_lane(lane)); ssm_pass2(P, lds, wave, opaque_lane(lane));
#endif
#endif
    GSYNC();
    {
        pg8::EpiGlu E{(const bf16*)(ws + WS_S), FW, P.b_glu, MIX, DM, FW};
        run_gemm(lds, (const bf16*)(ws + WS_S), (const bf16*)(ws + WS_WGLU), M, FW, FW, E, 0);
    }
    GSYNC();
    {
        pg8::EpiResidLNF<false, false> E{P.x, XA, mod + 2 * DM, ALPHA, DM, nullptr, nullptr, nullptr, (float*)(ws + WS_STAT), (unsigned*)(ws + WS_PCNT), P.ln_mix_g, P.ln_mix_b, mod + 3 * DM, mod + 4 * DM, H, nullptr};
        run_gemm_panel(lds, MIX, (const bf16*)(ws + WS_WOUT), DM, E);
    }
    GSYNC();
    ffn_part(P, 0, lds, bar, wave, lane);
    GSYNC();
    {
        const float* md = mod + 12288;
        {
            pg8::EpiQKRot E{(bf16*)(ws + WS_Q2), DM, 8, 0.125f * LOG2E, (bf16*)(ws + WS_K2), KVW, (const float*)(ws + WS_COS), (const float*)(ws + WS_SIN)};
            run_gemm(lds, H, (const bf16*)(ws + WS_WC1T), M, DM + KVW, DM, E, 0);
        }
        {
            pg8::EpiBf16<0> E{(bf16*)(ws + WS_VT2), M, nullptr, 0, 0, 1.0f};
            run_gemm(lds, (const bf16*)(ws + WS_WCVT), H, KVW, M, DM, E, 192);
        }
        { const unsigned v = VCU(lds); if (v >= 128u) convert_items(P, (LAS float*)(lds + wave * 16384), P.n_items_p0, P.n_items, (int)(v - 128u) * NWAVES + wave, 128 * NWAVES, opaque_lane(lane)); }
        GSYNC();
#ifndef SK_SWA
        swa_phase(P, lds, wave, opaque_lane(lane));
#if defined(PROBE_SWA2) || defined(PROBE_MISC2)
        swa_phase(P, lds, wave, opaque_lane(lane));
#endif
#endif
        GSYNC();
        {
            pg8::EpiResidLNF<true, false> E{XA, XA, md + 2 * DM, ALPHA, DM, (const float*)(ws + WS_STAT) + 1 * 2 * M, P.ln_ffn_g, P.ln_ffn_b, (float*)(ws + WS_STAT) + 2 * 2 * M,
                                           (unsigned*)(ws + WS_PCNT) + 2 * 4096, P.ln_mix_g + DM, P.ln_mix_b + DM, md + 3 * DM, md + 4 * DM, H, nullptr};
            run_gemm_panel(lds, MIX, (const bf16*)(ws + WS_WOC), DM, E);
        }
        GSYNC();
    }
    ffn_part(P, 1, lds, bar, wave, lane);
}

static void add_td(Params& p, int& n, int& items, const float* src, bf16* dst, int ld, int K, int ncols, int mode, int row_off) {
    TDesc& d = p.td[n++]; d.src = src; d.dst = dst; d.ld = ld; d.K = K; d.ncols = ncols; d.mode = mode; d.row_off = row_off; d.first = items;
    items += (K / 64) * (ncols / 32);
}
extern "C" void kernel_launch(void* const* d_in, const int* in_sizes, int n_in, void* d_out, int out_size, void* d_ws, size_t ws_size, hipStream_t stream) {
    static int grid = 0;
    if (grid == 0) {
        if (n_in != 28 || in_sizes[0] != M * DM || out_size != M * DM || ws_size < WS_END) {
            fprintf(stderr, "kernel_launch: unexpected problem (n_in %d, in0 %d, out %d, ws %zu); nothing launched\n", n_in, n_in > 0 ? in_sizes[0] : -1, out_size, ws_size); grid = -1; return; }
        int dev = 0, cus = 0, per_cu = 0;
        (void)hipGetDevice(&dev);
        (void)hipDeviceGetAttribute(&cus, hipDeviceAttributeMultiprocessorCount, dev);
        if (hipFuncSetAttribute((const void*)mega_fwd, hipFuncAttributeMaxDynamicSharedMemorySize, LDS_BYTES) != hipSuccess) { fprintf(stderr, "kernel_launch: hipFuncSetAttribute failed\n"); grid = -1; return; }
        if (hipOccupancyMaxActiveBlocksPerMultiprocessor(&per_cu, (const void*)mega_fwd, NTHR, LDS_BYTES) != hipSuccess || per_cu < 1) { fprintf(stderr, "kernel_launch: occupancy query gives %d\n", per_cu); per_cu = 1; }
        (void)hipGetLastError();
        grid = cus * 1;
        if (grid != 256) { fprintf(stderr, "kernel_launch: this kernel's fused LayerNorm epilogues need a 256-workgroup grid (256 CUs); got %d\n", grid); grid = -1; return; }
        fprintf(stderr, "kernel_launch: %d CUs, occupancy %d per CU, grid %d\n", cus, per_cu, grid);
    }
    if (grid < 0) return;
    unsigned char* ws = (unsigned char*)d_ws;
    (void)hipMemsetAsync(ws + WS_MOD, 0, CTL_ZERO_BYTES, stream);
    Params p; memset(&p, 0, sizeof(p));
    const float* const* in = (const float* const*)d_in;
    p.x = in[0]; p.c = in[1]; p.pos = (const int*)d_in[2];
    p.w_in_ab = in[3]; p.b_forget = in[4]; p.lam_re = in[5]; p.lam_im = in[6]; p.log_dt = in[7]; p.b_re = in[8]; p.b_im = in[9]; p.c_re = in[10]; p.c_im = in[11]; p.ssm_d = in[12];
    p.w_glu = in[13]; p.b_glu = in[14]; p.w_out_ab = in[15]; p.w_in_c = in[16]; p.sinks = in[17]; p.w_out_c = in[18]; p.w_ada = in[19]; p.b_ada = in[20];
    p.ln_mix_g = in[21]; p.ln_mix_b = in[22]; p.ln_ffn_g = in[23]; p.ln_ffn_b = in[24]; p.w_gate = in[25]; p.w_up = in[26]; p.w_down = in[27];
    p.out = (float*)d_out; p.ws = ws;
    int n = 0, items = 0;
    add_td(p, n, items, p.w_in_ab, (bf16*)(ws + WS_W1T), EVEN_IN, DM, 2 * FW, 0, 0);
    add_td(p, n, items, p.w_in_ab + 3 * FW + 8, (bf16*)(ws + WS_W1T), EVEN_IN, DM, FW, 0, 2 * FW);
    add_td(p, n, items, p.w_in_ab + 2 * FW, (bf16*)(ws + WS_WVT), EVEN_IN, DM, FW, 0, 0);
    add_td(p, n, items, p.w_glu, (bf16*)(ws + WS_WGLU), FW, FW, FW, 0, 0);
    add_td(p, n, items, p.w_out_ab, (bf16*)(ws + WS_WOUT), DM, DM, DM, 0, 0);
    add_td(p, n, items, p.w_in_c, (bf16*)(ws + WS_WC1T), ODD_IN, DM, DM + KVW, 0, 0);
    add_td(p, n, items, p.w_in_c + DM + KVW, (bf16*)(ws + WS_WCVT), ODD_IN, DM, KVW, 0, 0);
    add_td(p, n, items, p.w_out_c, (bf16*)(ws + WS_WOC), DM, DM, DM, 0, 0);
    for (int l = 0; l < 2; ++l) {
        if (l == 1) p.n_items_p0 = items;
        bf16* gu = (bf16*)(ws + (l == 0 ? WS_WGU0 : WS_WGU1)); bf16* dn = (bf16*)(ws + (l == 0 ? WS_WD0 : WS_WD1));
        add_td(p, n, items, p.w_gate + (size_t)l * DM * DFF, gu, DFF, DM, DFF, 1, 0);
        add_td(p, n, items, p.w_up + (size_t)l * DM * DFF, gu, DFF, DM, DFF, 1, 128);
        add_td(p, n, items, p.w_down + (size_t)l * DFF * DM, dn, DM, DFF, DM, 0, 0);
    }
    p.n_items = items;
    void* args[] = {&p};
    hipError_t e = hipLaunchCooperativeKernel((const void*)mega_fwd, dim3(grid), dim3(NTHR), args, LDS_BYTES, stream);
    if (e != hipSuccess) fprintf(stderr, "kernel_launch: cooperative launch failed: %s (grid %d)\n", hipGetErrorString(e), grid);
}
```

```cpp
#include <hip/hip_runtime.h>
#include <hip/hip_cooperative_groups.h>
#include <cstdio>
#include <cstdint>
#include <cstring>
namespace cg = cooperative_groups;
namespace pg8 {
#define PG8_LAS __attribute__((address_space(3)))
typedef unsigned short bf16_t;
typedef short bf16x8 __attribute__((ext_vector_type(8)));
typedef float f32x4 __attribute__((ext_vector_type(4)));
typedef unsigned u32x4 __attribute__((ext_vector_type(4)));
constexpr int BM = 256, BK = 64, HALF = 128, HTB = HALF * BK * 2  , STAGE_BYTES = 8 * HTB, NXCD = 8, WGM = 4;

__host__ __device__ __forceinline__ int lds_byte(int r, int c) { const int st = (r >> 4) * 2 + (c >> 5), rr = r & 15, cc = c & 31, ob = rr * 64 + cc * 2; return st * 1024 + (ob ^ (((ob >> 9) & 1) << 5)); }
__host__ __device__ __forceinline__ void stage_rc(int b, int& R, int& C) { const int st = b / 1024, sb = b % 1024, swz = sb ^ (((sb >> 9) & 1) << 5); R = (st >> 1) * 16 + swz / 64; C = (st & 1) * 32 + (swz % 64) / 2; }
__host__ __device__ __forceinline__ int perm32(int rho) { const int n = rho >> 4, i = rho & 15; return 8 * (i >> 2) + 4 * n + (i & 3); }

struct Unit { int pm, pn; };
struct Gemm { const bf16_t* A; const bf16_t* Bt; int M, N, K; };

struct StaticOrder {
    int nM, nN, nwg, G, c;
    __host__ __device__ void init(int M, int N, int G_, int c_) { nM = M / BM; nN = N / BM; nwg = nM * nN; G = G_; c = c_; }
    __host__ __device__ bool next(int i, Unit& u) const {
        const long L = (long)i * G + c; if (L >= nwg) return false;
        int wgid = (int)L; { const int q = nwg / NXCD, r = nwg % NXCD, xcd = wgid % NXCD, off = wgid / NXCD; wgid = (xcd < r ? xcd * (q + 1) : r * (q + 1) + (xcd - r) * q) + off; }
        const int nig = WGM * nN, gid = wgid / nig, fm = gid * WGM, gsz = (nM - fm) < WGM ? (nM - fm) : WGM;
        u.pm = fm + ((wgid % nig) % gsz); u.pn = (wgid % nig) / gsz; return true;
    }
    __device__ __forceinline__ void a_ready(const Unit&) const {}
    __device__ __forceinline__ void done(const Unit&) const {}
};

__device__ __forceinline__ unsigned cvt_pk_bf16(float lo, float hi) { unsigned r; asm volatile("v_cvt_pk_bf16_f32 %0, %1, %2" : "=v"(r) : "v"(lo), "v"(hi)); return r; }
typedef float f32x2 __attribute__((ext_vector_type(2)));
__device__ __forceinline__ f32x2 gelu_pk(f32x2 v) {
    const f32x2 av = __builtin_elementwise_abs(v), d = av * 0.2316418882f + 1.0f;
    f32x2 t; t.x = __builtin_amdgcn_rcpf(d.x); t.y = __builtin_amdgcn_rcpf(d.y);
    f32x2 q = t * 0.5307027145f + (-0.7265760135f); q = q * t + 0.7107068705f; q = q * t + (-0.142248368f); q = q * t + 0.127414796f; q = q * t;
    const f32x2 s = (v * v) * (-0.72134752044f);
    f32x2 e; e.x = __builtin_amdgcn_exp2f(s.x); e.y = __builtin_amdgcn_exp2f(s.y);
    const f32x2 m = v * (q * e), r = v - m;
    f32x2 o; o.x = v.x < 0.f ? m.x : r.x; o.y = v.y < 0.f ? m.y : r.y; return o;
}

template <int ACT  > struct EpiBf16 {
    static constexpr bool PERM = true, AFTER_DRAIN = false; static_assert(ACT == 0 || ACT == 1, "EpiBf16: ACT is 0 (none) or 1 (gelu_pk)");
    bf16_t* O; int ldc; const float* bias; int split_cols; size_t split_stride; float scale0;
    __device__ __forceinline__ void operator()(const f32x4 (&acc)[2][2][4][2], const Unit& u, int wr, int wc, int fr, int fq) const {
        const int row0 = u.pm * BM + wr * 64 + fr; int colt = u.pn * BM; bf16_t* base = O;
        float sc = 1.f; if (split_cols) { const int t = colt / split_cols; base += (size_t)t * split_stride; colt -= t * split_cols; if (t == 0) sc = scale0; }
        const int col0 = colt + wc * 32 + 8 * fq, bcol0 = u.pn * BM + wc * 32 + 8 * fq;
        f32x4 bv[2][2];
#pragma unroll
        for (int bj = 0; bj < 2; ++bj)
#pragma unroll
            for (int n = 0; n < 2; ++n) bv[bj][n] = bias ? *(const f32x4*)(bias + bcol0 + bj * HALF + 4 * n) : (f32x4){0.f, 0.f, 0.f, 0.f};
#pragma unroll
        for (int ai = 0; ai < 2; ++ai)
#pragma unroll
            for (int m = 0; m < 4; ++m) { bf16_t* rowp = base + (size_t)(row0 + ai * HALF + m * 16) * ldc + col0;
#pragma unroll
                for (int bj = 0; bj < 2; ++bj) { f32x4 v0 = acc[ai][bj][m][0] + bv[bj][0], v1 = acc[ai][bj][m][1] + bv[bj][1];
                    if (ACT == 1) { f32x2 a = gelu_pk((f32x2){v0[0], v0[1]}), b = gelu_pk((f32x2){v0[2], v0[3]}), c = gelu_pk((f32x2){v1[0], v1[1]}), d = gelu_pk((f32x2){v1[2], v1[3]});
                        v0 = (f32x4){a.x, a.y, b.x, b.y}; v1 = (f32x4){c.x, c.y, d.x, d.y}; }
                    v0 = v0 * sc; v1 = v1 * sc; u32x4 w; w.x = cvt_pk_bf16(v0[0], v0[1]); w.y = cvt_pk_bf16(v0[2], v0[3]); w.z = cvt_pk_bf16(v1[0], v1[1]); w.w = cvt_pk_bf16(v1[2], v1[3]);
                    *(u32x4*)(rowp + bj * HALF) = w; } }
    }
};
typedef unsigned u32x2 __attribute__((ext_vector_type(2)));
__device__ __forceinline__ float bf_lo(unsigned w) { return __builtin_bit_cast(float, w << 16); }
__device__ __forceinline__ float bf_hi(unsigned w) { return __builtin_bit_cast(float, w & 0xffff0000u); }
__device__ __forceinline__ float sigmoid_f(float v) { return __builtin_amdgcn_rcpf(1.0f + __builtin_amdgcn_exp2f(-1.4426950408889634f * v)); }

template <bool LNIN> struct EpiResidLN {
    static constexpr bool PERM = false, AFTER_DRAIN = false;
    const float* Xin; float* T; const float* gate; float alpha; int ldc; const float* stat_in; const float* lng; const float* lnb; float* stat_out;
    __device__ __forceinline__ void operator()(const f32x4 (&acc)[2][2][4][2], const Unit& u, int wr, int wc, int fr, int fq) const {
        const int col0 = u.pn * BM + wc * 32 + 4 * fq;
        f32x4 gv[2][2], lg[2][2], lb[2][2];
#pragma unroll
        for (int bj = 0; bj < 2; ++bj)
#pragma unroll
            for (int n = 0; n < 2; ++n) {
                gv[bj][n] = *(const f32x4*)(gate + col0 + bj * HALF + n * 16);
                if (LNIN) { lg[bj][n] = *(const f32x4*)(lng + col0 + bj * HALF + n * 16); lb[bj][n] = *(const f32x4*)(lnb + col0 + bj * HALF + n * 16); }
            }
#pragma unroll
        for (int ai = 0; ai < 2; ++ai)
#pragma unroll
            for (int m = 0; m < 4; ++m) {
                const int row = u.pm * BM + ai * HALF + wr * 64 + m * 16 + fr;
                const size_t off = (size_t)row * ldc + col0;
                float mean = 0.f, rstd = 1.f;
                if (LNIN) { const float s1 = stat_in[2 * row], s2 = stat_in[2 * row + 1]; mean = s1 * (1.0f / 2048.0f); const float var = s2 * (1.0f / 2048.0f) - mean * mean; rstd = 1.0f / sqrtf(var + 1e-5f); }
                float s = 0.f, ss = 0.f;
#pragma unroll
                for (int bj = 0; bj < 2; ++bj)
#pragma unroll
                    for (int n = 0; n < 2; ++n) {
                        f32x4 xv = *(const f32x4*)(Xin + off + bj * HALF + n * 16);
                        if (LNIN) xv = (xv - mean) * rstd * lg[bj][n] + lb[bj][n];
                        const f32x4 o = xv * alpha + gv[bj][n] * acc[ai][bj][m][n];
                        *(f32x4*)(T + off + bj * HALF + n * 16) = o;
                        s += (o[0] + o[1]) + (o[2] + o[3]); ss += (o[0] * o[0] + o[1] * o[1]) + (o[2] * o[2] + o[3] * o[3]);
                    }
                s += __shfl_xor(s, 16); s += __shfl_xor(s, 32); ss += __shfl_xor(ss, 16); ss += __shfl_xor(ss, 32);
                if (fq == 0) { atomicAdd(stat_out + 2 * row, s); atomicAdd(stat_out + 2 * row + 1, ss); }
                asm volatile("" ::: "memory");
            }
    }
};

struct PanelOrder {
    int c;
    __host__ __device__ void init(int c_) { c = c_; }
    __host__ __device__ bool next(int i, Unit& u) const { if (i >= 2) return false; const int j = c >> 3; u.pm = 8 * (c & 7) + 4 * i + (j & 3); u.pn = j >> 2; return true; }
    __device__ __forceinline__ void a_ready(const Unit&) const {}
    __device__ __forceinline__ void done(const Unit&) const {}
};
template <bool LNIN, bool FINAL> struct EpiResidLNF {
    static constexpr bool PERM = false, AFTER_DRAIN = false;
    const float* Xin; float* T; const float* gate; float alpha; int ldc; const float* stat_in; const float* lng_in; const float* lnb_in;
    float* stat_out; unsigned* cnt; const float* lng; const float* lnb; const float* sh; const float* sc; bf16_t* H; float* OUT;
    __device__ __forceinline__ void operator()(const f32x4 (&acc_)[2][2][4][2], const Unit& u, int wr, int wc, int fr, int fq) const {
        f32x4 (&acc)[2][2][4][2] = const_cast<f32x4 (&)[2][2][4][2]>(acc_);
        asm volatile("" : "+v"(fr), "+v"(fq));
        const int col0 = u.pn * BM + wc * 32 + 4 * fq;
        {
#pragma unroll
            for (int ai = 0; ai < 2; ++ai)
#pragma unroll
                for (int m = 0; m < 4; ++m) {
                    const int row = u.pm * BM + ai * HALF + wr * 64 + m * 16 + fr;
                    const size_t off = (size_t)row * ldc + col0;
                    float mean = 0.f, rstd = 1.f;
                    if (LNIN) { const float s1 = stat_in[2 * row], s2 = stat_in[2 * row + 1]; mean = s1 * (1.0f / 2048.0f); const float var = s2 * (1.0f / 2048.0f) - mean * mean; rstd = 1.0f / sqrtf(var + 1e-5f); }
                    float s = 0.f, ss = 0.f;
#pragma unroll
                    for (int bj = 0; bj < 2; ++bj)
#pragma unroll
                        for (int n = 0; n < 2; ++n) {
                            f32x4 xv = *(const f32x4*)(Xin + off + bj * HALF + n * 16);
                            const int cc = col0 + bj * HALF + n * 16;
                            if (LNIN) xv = (xv - mean) * rstd * *(const f32x4*)(lng_in + cc) + *(const f32x4*)(lnb_in + cc);
                            const f32x4 o = xv * alpha + *(const f32x4*)(gate + cc) * acc[ai][bj][m][n];
                            acc[ai][bj][m][n] = o;
                            if (!FINAL) *(f32x4*)(T + off + bj * HALF + n * 16) = o;
                            s += (o[0] + o[1]) + (o[2] + o[3]); ss += (o[0] * o[0] + o[1] * o[1]) + (o[2] * o[2] + o[3] * o[3]);
                        }
                    s += __shfl_xor(s, 16); s += __shfl_xor(s, 32); ss += __shfl_xor(ss, 16); ss += __shfl_xor(ss, 32);
                    if (fq == 0) { atomicAdd(stat_out + 2 * row, s); atomicAdd(stat_out + 2 * row + 1, ss); }
                    if (m == 3) asm volatile("" ::: "memory");
                }
        }
        f32x4 a2[2][2], b2[2][2];
#pragma unroll
        for (int bj = 0; bj < 2; ++bj)
#pragma unroll
            for (int n = 0; n < 2; ++n) {
                const int cc = col0 + bj * HALF + n * 16;
                a2[bj][n] = *(const f32x4*)(lng + cc); b2[bj][n] = *(const f32x4*)(lnb + cc);
                if (!FINAL) { const f32x4 s1 = *(const f32x4*)(sc + cc) + 1.0f; a2[bj][n] = a2[bj][n] * s1; b2[bj][n] = b2[bj][n] * s1 + *(const f32x4*)(sh + cc); }
            }
        asm volatile("s_waitcnt vmcnt(0) lgkmcnt(0)" ::: "memory");
        unsigned* c = cnt + 64 * u.pm;
        if ((threadIdx.x & 63) == 0) __hip_atomic_fetch_add(c, 1u, __ATOMIC_RELAXED, __HIP_MEMORY_SCOPE_AGENT);
        if (__builtin_amdgcn_readfirstlane(threadIdx.x >> 6) == 0) {
            unsigned spins = 0;
            while ((unsigned)__builtin_amdgcn_readfirstlane(__hip_atomic_load(c, __ATOMIC_RELAXED, __HIP_MEMORY_SCOPE_AGENT)) < 64u) {
                __builtin_amdgcn_s_sleep(4);
                if (++spins > (1u << 23)) break;
            }
        }
        __builtin_amdgcn_s_barrier();
        asm volatile("" ::: "memory");
        float mean8[8], rstd8[8];
#pragma unroll
        for (int ai = 0; ai < 2; ++ai)
#pragma unroll
            for (int m = 0; m < 4; ++m) {
                const int row = u.pm * BM + ai * HALF + wr * 64 + m * 16 + fr;
                const float s1 = __hip_atomic_load(stat_out + 2 * row, __ATOMIC_RELAXED, __HIP_MEMORY_SCOPE_AGENT), s2 = __hip_atomic_load(stat_out + 2 * row + 1, __ATOMIC_RELAXED, __HIP_MEMORY_SCOPE_AGENT);
                const float mean = s1 * (1.0f / 2048.0f), var = s2 * (1.0f / 2048.0f) - mean * mean;
                mean8[ai * 4 + m] = mean; rstd8[ai * 4 + m] = 1.0f / sqrtf(var + 1e-5f);
            }
#pragma unroll
        for (int bj = 0; bj < 2; ++bj)
#pragma unroll
            for (int n = 0; n < 2; ++n) {
                const int cc = col0 + bj * HALF + n * 16;
#pragma unroll
                for (int ai = 0; ai < 2; ++ai)
#pragma unroll
                    for (int m = 0; m < 4; ++m) {
                        const size_t off = (size_t)(u.pm * BM + ai * HALF + wr * 64 + m * 16 + fr) * ldc + cc;
                        const f32x4 y = (acc[ai][bj][m][n] - mean8[ai * 4 + m]) * rstd8[ai * 4 + m] * a2[bj][n] + b2[bj][n];
                        if (FINAL) *(f32x4*)(OUT + off) = y;
                        else { u32x2 w; w.x = cvt_pk_bf16(y[0], y[1]); w.y = cvt_pk_bf16(y[2], y[3]); *(u32x2*)(H + off) = w; }
                    }
                asm volatile("" ::: "memory");
            }
    }
};

struct EpiSwiglu {
    static constexpr bool PERM = true, AFTER_DRAIN = false;
    bf16_t* O; int ldo;
    __device__ __forceinline__ void operator()(const f32x4 (&acc)[2][2][4][2], const Unit& u, int wr, int wc, int fr, int fq) const {
        const int row0 = u.pm * BM + wr * 64 + fr, col0 = u.pn * HALF + wc * 32 + 8 * fq;
#pragma unroll
        for (int ai = 0; ai < 2; ++ai)
#pragma unroll
            for (int m = 0; m < 4; ++m) {
                bf16_t* rowp = O + (size_t)(row0 + ai * HALF + m * 16) * ldo + col0;
                float v[8];
#pragma unroll
                for (int n = 0; n < 2; ++n)
#pragma unroll
                    for (int i = 0; i < 4; ++i) { const float gt = acc[ai][0][m][n][i], up = acc[ai][1][m][n][i]; v[4 * n + i] = gt * sigmoid_f(gt) * up; }
                u32x4 w; w.x = cvt_pk_bf16(v[0], v[1]); w.y = cvt_pk_bf16(v[2], v[3]); w.z = cvt_pk_bf16(v[4], v[5]); w.w = cvt_pk_bf16(v[6], v[7]);
                *(u32x4*)rowp = w;
            }
    }
};

struct EpiGlu {
    static constexpr bool PERM = true, AFTER_DRAIN = false;
    const bf16_t* S; int lds_; const float* b; bf16_t* O; int ldo; int ocol0;
    __device__ __forceinline__ void operator()(const f32x4 (&acc)[2][2][4][2], const Unit& u, int wr, int wc, int fr, int fq) const {
        const int row0 = u.pm * BM + wr * 64 + fr, col0 = u.pn * BM + wc * 32 + 8 * fq;
        f32x4 bv[2][2];
#pragma unroll
        for (int bj = 0; bj < 2; ++bj)
#pragma unroll
            for (int n = 0; n < 2; ++n) bv[bj][n] = *(const f32x4*)(b + col0 + bj * HALF + 4 * n);
#pragma unroll
        for (int ai = 0; ai < 2; ++ai)
#pragma unroll
            for (int m = 0; m < 4; ++m) {
                const size_t row = (size_t)(row0 + ai * HALF + m * 16);
#pragma unroll
                for (int bj = 0; bj < 2; ++bj) {
                    const u32x4 sw = *(const u32x4*)(S + row * lds_ + col0 + bj * HALF);
                    const f32x4 z0 = acc[ai][bj][m][0] + bv[bj][0], z1 = acc[ai][bj][m][1] + bv[bj][1];
                    u32x4 w;
                    w.x = cvt_pk_bf16(bf_lo(sw.x) * sigmoid_f(z0[0]), bf_hi(sw.x) * sigmoid_f(z0[1]));
                    w.y = cvt_pk_bf16(bf_lo(sw.y) * sigmoid_f(z0[2]), bf_hi(sw.y) * sigmoid_f(z0[3]));
                    w.z = cvt_pk_bf16(bf_lo(sw.z) * sigmoid_f(z1[0]), bf_hi(sw.z) * sigmoid_f(z1[1]));
                    w.w = cvt_pk_bf16(bf_lo(sw.w) * sigmoid_f(z1[2]), bf_hi(sw.w) * sigmoid_f(z1[3]));
                    *(u32x4*)(O + row * ldo + ocol0 + col0 + bj * HALF) = w;
                }
                asm volatile("" ::: "memory");
            }
    }
};

struct EpiQKRot {
    static constexpr bool PERM = true, AFTER_DRAIN = false;
    bf16_t* O0; int ld0; int nt0; float scale0; bf16_t* O1; int ld1; const float* COS; const float* SIN;
    __device__ __forceinline__ void operator()(const f32x4 (&acc)[2][2][4][2], const Unit& u, int wr, int wc, int fr, int fq) const {
        const int row0 = u.pm * BM + wr * 64 + fr;
        const bool first = u.pn < nt0;
        bf16_t* base = first ? O0 : O1; const int ld = first ? ld0 : ld1; const float sc = first ? scale0 : 1.0f;
        const int col0 = (first ? u.pn : u.pn - nt0) * BM + wc * 32 + 8 * fq;
        const bool rotw = (wc & 1) == 0;
#pragma unroll
        for (int ai = 0; ai < 2; ++ai)
#pragma unroll
            for (int m = 0; m < 4; ++m) {
                const size_t row = (size_t)(row0 + ai * HALF + m * 16);
                f32x4 cs[2], sn[2];
                if (rotw) {
#pragma unroll
                    for (int n = 0; n < 2; ++n) { cs[n] = *(const f32x4*)(COS + row * 8 + 4 * n); sn[n] = *(const f32x4*)(SIN + row * 8 + 4 * n); }
                }
#pragma unroll
                for (int bj = 0; bj < 2; ++bj) {
                    f32x4 v0 = acc[ai][bj][m][0], v1 = acc[ai][bj][m][1];
                    if (rotw) {
                        f32x4 p0, p1;
#pragma unroll
                        for (int i = 0; i < 4; ++i) { p0[i] = __shfl_xor(v0[i], 16); p1[i] = __shfl_xor(v1[i], 16); }
                        if (fq == 0) { v0 = v0 * cs[0] - p0 * sn[0]; v1 = v1 * cs[1] - p1 * sn[1]; }
                        else if (fq == 1) { v0 = v0 * cs[0] + p0 * sn[0]; v1 = v1 * cs[1] + p1 * sn[1]; }
                    }
                    v0 = v0 * sc; v1 = v1 * sc;
                    u32x4 w; w.x = cvt_pk_bf16(v0[0], v0[1]); w.y = cvt_pk_bf16(v0[2], v0[3]); w.z = cvt_pk_bf16(v1[0], v1[1]); w.w = cvt_pk_bf16(v1[2], v1[3]);
                    *(u32x4*)(base + row * ld + col0 + bj * HALF) = w;
                }
                asm volatile("" ::: "memory");
            }
    }
};
template <class Epi, class Sched, bool ALIGN_EPI = false, bool SP2 = false>
__device__ __forceinline__ void gemm_phase(PG8_LAS unsigned char* lds, const Gemm g, const Sched& S, const Epi& E) {
    int tid_ = threadIdx.x; asm volatile("" : "+v"(tid_));
    const int tid = tid_, wid = __builtin_amdgcn_readfirstlane(tid >> 6), lane = tid & 63, wr = wid >> 2, wc = wid & 3, fr = lane & 15, fq = lane >> 4;
    const int K = g.K, nt = K / BK;
    unsigned voffA[2], voffB[2];
#pragma unroll
    for (int i = 0; i < 2; ++i) { int R, C; stage_rc(tid * 16 + i * 8192, R, C); const int Rb = Epi::PERM ? ((R & ~31) + perm32(R & 31)) : R;
        voffA[i] = (unsigned)(R * K + C) * 2u; voffB[i] = (unsigned)(Rb * K + C) * 2u; }
    const size_t kstep = (size_t)(BK * 2);
    const size_t hstep = (size_t)HALF * K * 2;
    const size_t tstep = 2 * hstep;
    const unsigned ldsw = (unsigned)wid * 1024u;
    const int aoff = lds_byte(wr * 64 + fr, fq * 8), boff = lds_byte(wc * 32 + fr, fq * 8);
#define PG8_SA(b, h) (((b) * 2 + (h)) * HTB)
#define PG8_SB(b, h) ((4 + (b) * 2 + (h)) * HTB)
#define PG8_STAGE(bufoff, gbase, voff) do { _Pragma("unroll") for (int _i = 0; _i < 2; ++_i) \
        __builtin_amdgcn_global_load_lds((const unsigned*)((const char*)(gbase) + (voff)[_i]), (PG8_LAS unsigned*)(lds + (bufoff) + ldsw + _i * 8192), 16, 0, 0); } while (0)
#define PG8_LDA(dst, b, h) do { _Pragma("unroll") for (int m = 0; m < 4; ++m) _Pragma("unroll") for (int k = 0; k < 2; ++k) dst[m][k] = *(const PG8_LAS bf16x8*)(lds + PG8_SA(b, h) + aoff + m * 2048 + k * 1024); } while (0)
#define PG8_LDB(dst, b, h) do { _Pragma("unroll") for (int n = 0; n < 2; ++n) _Pragma("unroll") for (int k = 0; k < 2; ++k) dst[n][k] = *(const PG8_LAS bf16x8*)(lds + PG8_SB(b, h) + boff + n * 2048 + k * 1024); } while (0)
#define PG8_MMA(ai, bj, At, Bt) do { __builtin_amdgcn_s_setprio(1); _Pragma("unroll") for (int m = 0; m < 4; ++m) _Pragma("unroll") for (int n = 0; n < 2; ++n) _Pragma("unroll") for (int k = 0; k < 2; ++k) \
        acc[ai][bj][m][n] = __builtin_amdgcn_mfma_f32_16x16x32_bf16(Bt[n][k], At[m][k], acc[ai][bj][m][n], 0, 0, 0); __builtin_amdgcn_s_setprio(0); } while (0)
#define PG8_WAIT_V(n) asm volatile("s_waitcnt vmcnt(" #n ")" ::: "memory")
#define PG8_WAIT_L(n) asm volatile("s_waitcnt lgkmcnt(" #n ")" ::: "memory")
#define PG8_BAR __builtin_amdgcn_s_barrier()
#define PG8_SCHED __builtin_amdgcn_sched_barrier(0)
    Unit cur, nxt; int ui = 0;
    if (!S.next(0, cur)) return;
    f32x4 acc[2][2][4][2];
#pragma unroll
    for (int a = 0; a < 2; ++a)
#pragma unroll
        for (int b = 0; b < 2; ++b)
#pragma unroll
            for (int m = 0; m < 4; ++m)
#pragma unroll
                for (int n = 0; n < 2; ++n) acc[a][b][m][n] = (f32x4){0.f, 0.f, 0.f, 0.f};
    bf16x8 At[4][2], B0[2][2], B1[2][2];
    const char* cA = (const char*)g.A + (size_t)cur.pm * tstep; const char* cB = (const char*)g.Bt + (size_t)cur.pn * tstep;
    S.a_ready(cur);
    if constexpr (SP2) {
        PG8_STAGE(PG8_SB(0, 0), cB, voffB); PG8_STAGE(PG8_SB(0, 1), cB + hstep, voffB); PG8_STAGE(PG8_SA(0, 0), cA, voffA); PG8_STAGE(PG8_SA(0, 1), cA + hstep, voffA);
        if (wr == 1) PG8_BAR;
        PG8_WAIT_V(2); PG8_BAR;
        PG8_STAGE(PG8_SB(1, 0), cB + kstep, voffB); PG8_STAGE(PG8_SA(1, 0), cA + kstep, voffA); PG8_STAGE(PG8_SB(1, 1), cB + hstep + kstep, voffB);
        PG8_WAIT_V(6); PG8_BAR;
    } else {
        PG8_STAGE(PG8_SB(0, 0), cB, voffB); PG8_STAGE(PG8_SA(0, 0), cA, voffA); PG8_STAGE(PG8_SB(0, 1), cB + hstep, voffB); PG8_STAGE(PG8_SA(0, 1), cA + hstep, voffA);
        if (wr == 1) PG8_BAR;
        PG8_WAIT_V(4); PG8_BAR;
        PG8_STAGE(PG8_SB(1, 0), cB + kstep, voffB); PG8_STAGE(PG8_SA(1, 0), cA + kstep, voffA); PG8_STAGE(PG8_SB(1, 1), cB + hstep + kstep, voffB);
        PG8_WAIT_V(6); PG8_BAR;
    }
    for (;;) {
        const bool has_next = S.next(ui + 1, nxt);
        const char* nA = has_next ? (const char*)g.A + (size_t)nxt.pm * tstep : cA; const char* nB = has_next ? (const char*)g.Bt + (size_t)nxt.pn * tstep : cB;
        for (int t = 0; t < nt; t += 2) {
            const bool last = (t == nt - 2);
            const char* a1 = cA + (size_t)(t + 1) * kstep;
            const char* a2 = last ? nA : cA + (size_t)(t + 2) * kstep; const char* b2 = last ? nB : cB + (size_t)(t + 2) * kstep;
            const char* a3 = a2 + kstep; const char* b3 = b2 + kstep;
            if (last && has_next) S.a_ready(nxt);
            if constexpr (SP2) {
            PG8_LDB(B0, 0, 0); PG8_LDB(B1, 0, 1); PG8_SCHED; PG8_LDA(At, 0, 0); PG8_STAGE(PG8_SA(1, 1), a1 + hstep, voffA);
            PG8_WAIT_V(8); PG8_WAIT_L(0); PG8_BAR; PG8_MMA(0, 0, At, B0); PG8_MMA(0, 1, At, B1); PG8_BAR; PG8_SCHED;
            PG8_LDA(At, 0, 1); PG8_STAGE(PG8_SB(0, 0), b2, voffB); PG8_STAGE(PG8_SB(0, 1), b2 + hstep, voffB); PG8_STAGE(PG8_SA(0, 0), a2, voffA);
            PG8_WAIT_V(8); PG8_WAIT_L(0); PG8_BAR; PG8_MMA(1, 0, At, B0); PG8_MMA(1, 1, At, B1); PG8_BAR; PG8_SCHED;
            PG8_LDB(B0, 1, 0); PG8_LDB(B1, 1, 1); PG8_SCHED; PG8_LDA(At, 1, 0); PG8_STAGE(PG8_SA(0, 1), a2 + hstep, voffA);
            PG8_WAIT_V(8); PG8_WAIT_L(0); PG8_BAR; PG8_MMA(0, 0, At, B0); PG8_MMA(0, 1, At, B1); PG8_BAR; PG8_SCHED;
            PG8_LDA(At, 1, 1); PG8_STAGE(PG8_SB(1, 0), b3, voffB); PG8_STAGE(PG8_SB(1, 1), b3 + hstep, voffB); PG8_STAGE(PG8_SA(1, 0), a3, voffA);
            PG8_WAIT_V(8); PG8_WAIT_L(0); PG8_BAR; PG8_MMA(1, 0, At, B0); PG8_MMA(1, 1, At, B1); PG8_BAR; PG8_SCHED;
            } else {
            PG8_LDB(B0, 0, 0); PG8_SCHED; PG8_LDA(At, 0, 0); PG8_STAGE(PG8_SA(1, 1), a1 + hstep, voffA);
            PG8_WAIT_L(8); PG8_BAR; PG8_WAIT_L(0); PG8_MMA(0, 0, At, B0); PG8_BAR; PG8_SCHED;
            PG8_LDB(B1, 0, 1); PG8_STAGE(PG8_SB(0, 0), b2, voffB);
            PG8_BAR; PG8_WAIT_L(0); PG8_MMA(0, 1, At, B1); PG8_BAR;
            PG8_LDA(At, 0, 1); PG8_STAGE(PG8_SA(0, 0), a2, voffA);
            PG8_BAR; PG8_WAIT_L(0); PG8_MMA(1, 0, At, B0); PG8_BAR; PG8_SCHED;
            PG8_STAGE(PG8_SB(0, 1), b2 + hstep, voffB);
            PG8_WAIT_V(6); PG8_BAR; PG8_MMA(1, 1, At, B1); PG8_BAR;
            PG8_LDB(B0, 1, 0); PG8_SCHED; PG8_LDA(At, 1, 0); PG8_STAGE(PG8_SA(0, 1), a2 + hstep, voffA);
            PG8_WAIT_L(8); PG8_BAR; PG8_WAIT_L(0); PG8_MMA(0, 0, At, B0); PG8_BAR; PG8_SCHED;
            PG8_LDB(B1, 1, 1); PG8_STAGE(PG8_SB(1, 0), b3, voffB);
            PG8_BAR; PG8_WAIT_L(0); PG8_MMA(0, 1, At, B1); PG8_BAR;
            PG8_LDA(At, 1, 1); PG8_STAGE(PG8_SA(1, 0), a3, voffA);
            PG8_BAR; PG8_WAIT_L(0); PG8_MMA(1, 0, At, B0); PG8_BAR; PG8_SCHED;
            PG8_STAGE(PG8_SB(1, 1), b3 + hstep, voffB);
            PG8_WAIT_V(6); PG8_BAR; PG8_MMA(1, 1, At, B1); PG8_BAR;
            }
        }
        if constexpr (ALIGN_EPI) { if (wr == 0) PG8_BAR; }
        if constexpr (!Epi::AFTER_DRAIN) { E(acc, cur, wr, wc, fr, fq); S.done(cur); }
        if (!has_next) break;
#pragma unroll
        for (int a = 0; a < 2; ++a)
#pragma unroll
            for (int b = 0; b < 2; ++b)
#pragma unroll
                for (int m = 0; m < 4; ++m)
#pragma unroll
                    for (int n = 0; n < 2; ++n) acc[a][b][m][n] = (f32x4){0.f, 0.f, 0.f, 0.f};
        cur = nxt; cA = nA; cB = nB; ++ui;
        if constexpr (ALIGN_EPI) { if (wr == 1) PG8_BAR; }
    }
    PG8_WAIT_V(0);
    if constexpr (!ALIGN_EPI) { if (wr == 0) PG8_BAR; }
    PG8_BAR;
    if constexpr (Epi::AFTER_DRAIN) { E.fused(acc, cur, wr, wc, fr, fq, lds, wid, lane); S.done(cur); }
#undef PG8_SA
#undef PG8_SB
#undef PG8_STAGE
#undef PG8_LDA
#undef PG8_LDB
#undef PG8_MMA
#undef PG8_WAIT_V
#undef PG8_WAIT_L
#undef PG8_BAR
#undef PG8_SCHED
}
}
#define LAS __attribute__((address_space(3)))
typedef unsigned short bf16;
typedef float f32x4 __attribute__((ext_vector_type(4)));
typedef float f32x2 __attribute__((ext_vector_type(2)));
typedef float f32x16 __attribute__((ext_vector_type(16)));
typedef short bf16x8 __attribute__((ext_vector_type(8)));
typedef short s16x4 __attribute__((ext_vector_type(4)));
typedef unsigned u32x4 __attribute__((ext_vector_type(4)));
typedef unsigned u32x2 __attribute__((ext_vector_type(2)));

constexpr int M = 16384, DM = 2048, FW = 1024, EVEN_IN = 4104, ODD_IN = 2560, KVW = 256, DFF = 5632;
constexpr int NWAVES = 8, NTHR = 512;
constexpr float LN_EPS = 1e-5f;
constexpr float ALPHA = 1.4142135623730951f;
constexpr float LOG2E = 1.4426950408889634f;
constexpr int LDS_BYTES = 147456;
constexpr int LDS_BARST = LDS_BYTES - 16;
#define VCU(lds) (((volatile LAS unsigned*)((lds) + LDS_BARST))[2])

constexpr size_t MiB = 1u << 20;
constexpr size_t WS_MOD = 0;
constexpr size_t CTL_ZERO_BYTES = 2 * MiB;
constexpr size_t WS_PCNT = 1 * MiB + 512 * 1024;
constexpr size_t WS_STAT = 1 * MiB;
constexpr int CW_KMAX2 = 24576, CW_QN2 = 24640;
constexpr size_t WS_W1T = 2 * MiB, WS_WVT = 14 * MiB, WS_WGLU = 18 * MiB, WS_WOUT = 20 * MiB, WS_WC1T = 28 * MiB, WS_WCVT = 38 * MiB, WS_WOC = 40 * MiB;
constexpr size_t WS_WGU0 = 48 * MiB, WS_WGU1 = 92 * MiB, WS_WD0 = 136 * MiB, WS_WD1 = 158 * MiB;
constexpr size_t WS_H = 180 * MiB;
constexpr size_t WS_R = 244 * MiB;
constexpr size_t WS_Q = WS_R, WS_K = WS_R + 32 * MiB, WS_U = WS_R + 64 * MiB, WS_VT = WS_R + 96 * MiB, WS_S = WS_R + 128 * MiB, WS_MIX = WS_R + 160 * MiB;
constexpr size_t WS_MID = WS_R;
constexpr size_t WS_Q2 = WS_R, WS_K2 = WS_R + 64 * MiB, WS_VT2 = WS_R + 72 * MiB;
constexpr size_t WS_E = 468 * MiB;
constexpr size_t WS_LOGF = 476 * MiB, WS_F = WS_LOGF + MiB / 2, WS_COS = 477 * MiB, WS_SIN = WS_COS + MiB / 2;
constexpr size_t WS_END = 478 * MiB;

struct TDesc { const float* src; bf16* dst; int ld, K, ncols, mode, row_off, first; };
constexpr int NTD = 14;
struct Params {
    const float *x, *c; const int* pos;
    const float *w_in_ab, *b_forget, *lam_re, *lam_im, *log_dt, *b_re, *b_im, *c_re, *c_im, *ssm_d, *w_glu, *b_glu, *w_out_ab, *w_in_c, *sinks, *w_out_c,
        *w_ada, *b_ada, *ln_mix_g, *ln_mix_b, *ln_ffn_g, *ln_ffn_b, *w_gate, *w_up, *w_down;
    float* out; unsigned char* ws;
    TDesc td[NTD]; int n_items; int n_items_p0;
};

__device__ __forceinline__ unsigned f2bf(float f) { unsigned u = __builtin_bit_cast(unsigned, f); return (u + 0x7fffu + ((u >> 16) & 1u)) >> 16; }
__device__ __forceinline__ unsigned pk2(float lo, float hi) { return f2bf(lo) | (f2bf(hi) << 16); }
__device__ __forceinline__ float bflo(unsigned w) { return __builtin_bit_cast(float, w << 16); }
__device__ __forceinline__ float bfhi(unsigned w) { return __builtin_bit_cast(float, w & 0xffff0000u); }
__device__ __forceinline__ float wave_sum(float v) {
#pragma unroll
    for (int o = 1; o < 64; o <<= 1) v += __shfl_xor(v, o);
    return v;
}
__device__ __forceinline__ void sincos_d(double ang, double& s, double& c) {
    const double TWO_PI = 6.283185307179586476925287, INV_TWO_PI = 0.159154943091895335768884;
    const double k = __builtin_rint(ang * INV_TWO_PI);
    const double r = __builtin_fma(-k, TWO_PI, ang) - k * 2.449293598294706e-16;
    const double r2 = r * r;
    double ss = 1.0 / 1.0888869450418352e28;
    double cc = 1.0 / 4.0329146112660565e26;
    const double fs[13] = {1.0 / 1.5511210043330986e25, 1.0 / 2.5852016738884978e22, 1.0 / 5.109094217170944e19, 1.0 / 1.21645100408832e17, 1.0 / 355687428096000.0, 1.0 / 1307674368000.0,
                           1.0 / 6227020800.0, 1.0 / 39916800.0, 1.0 / 362880.0, 1.0 / 5040.0, 1.0 / 120.0, 1.0 / 6.0, 1.0};
    const double fc[13] = {1.0 / 6.204484017332394e23, 1.0 / 1.1240007277776077e21, 1.0 / 2.43290200817664e18, 1.0 / 6402373705728000.0, 1.0 / 20922789888000.0, 1.0 / 87178291200.0,
                           1.0 / 479001600.0, 1.0 / 3628800.0, 1.0 / 40320.0, 1.0 / 720.0, 1.0 / 24.0, 1.0 / 2.0, 1.0};
#pragma unroll
    for (int i = 0; i < 13; ++i) { ss = fs[i] - ss * r2; cc = fc[i] - cc * r2; }
    s = ss * r; c = cc;
}

__device__ __forceinline__ void transpose_item(const TDesc& d, LAS float* scr, int item, int lane) {
    const int nblk = d.ncols / 32, kb = item / nblk, nb = item % nblk, k0 = 64 * kb, n0 = 32 * nb;
    const float* W = d.src;
#pragma unroll
    for (int i = 0; i < 32; ++i) { const int kk = 2 * i + (lane >> 5); scr[kk * 33 + (lane & 31)] = W[(size_t)(k0 + kk) * d.ld + n0 + (lane & 31)]; }
    asm volatile("s_waitcnt lgkmcnt(0)" ::: "memory");
    const int c = lane & 7;
    const int drow0 = (d.mode == 0) ? (d.row_off + n0) : ((n0 >> 7) * 256 + (n0 & 127) + d.row_off);
#pragma unroll
    for (int j = 0; j < 4; ++j) { const int n = (lane >> 3) + 8 * j; const LAS float* s = scr + (8 * c) * 33 + n;
        u32x4 o; o.x = pk2(s[0 * 33], s[1 * 33]); o.y = pk2(s[2 * 33], s[3 * 33]); o.z = pk2(s[4 * 33], s[5 * 33]); o.w = pk2(s[6 * 33], s[7 * 33]);
        *(u32x4*)(d.dst + (size_t)(drow0 + n) * d.K + k0 + 8 * c) = o; }
    asm volatile("s_waitcnt lgkmcnt(0)" ::: "memory");
}

__device__ __forceinline__ void convert_items(const Params& P, LAS float* scr, int it_lo, int it_hi, int w, int nw, int lane) {
    for (int it = it_lo + w; it < it_hi; it += nw) {
        int di = 0;
#pragma unroll
        for (int j = 1; j < NTD; ++j) di = (it >= P.td[j].first) ? j : di;
        const TDesc d = P.td[di];
        transpose_item(d, scr, it - d.first, lane);
    }
}
__device__ __forceinline__ void p0_prologue(const Params& P, LAS unsigned char* lds, int wave, int lane) {
    LAS float* scr = (LAS float*)(lds + wave * 16384);
    const int gw = blockIdx.x * NWAVES + wave, NGW = gridDim.x * NWAVES;
    float* mod = (float*)(P.ws + WS_MOD);
    for (int it = gw; it < 96 * 64; it += NGW) {
        const int nb = it % 96, ks = it / 96, l = nb / 48, n0 = (nb % 48) * 256 + 4 * lane;
        const float* W = P.w_ada + ((size_t)l * DM + ks * 32) * 12288 + n0;
        f32x4 acc = {0.f, 0.f, 0.f, 0.f};
#pragma unroll
        for (int k = 0; k < 32; ++k) { const float cv = P.c[ks * 32 + k]; const float sv = cv * __builtin_amdgcn_rcpf(1.0f + __expf(-cv)); const f32x4 w = *(const f32x4*)(W + (size_t)k * 12288); acc += w * sv; }
        if (ks == 0) acc += *(const f32x4*)(P.b_ada + l * 12288 + n0);
        float* o = mod + l * 12288 + n0;
        atomicAdd(o + 0, acc[0]); atomicAdd(o + 1, acc[1]); atomicAdd(o + 2, acc[2]); atomicAdd(o + 3, acc[3]);
    }
    {
        float* COS = (float*)(P.ws + WS_COS); float* SIN = (float*)(P.ws + WS_SIN);
        const double inv_freq[8] = {1.0, 0.19392274474868576, 0.03760603093086393, 0.007292664737217109, 0.001414213562373095, 0.0002742481756762073, 5.318295896944988e-05, 1.031338537721246e-05};
        for (int e = blockIdx.x * NTHR + threadIdx.x; e < M * 8; e += gridDim.x * NTHR) {
            const int t = e >> 3, i = e & 7;
            double fr = inv_freq[0];
#pragma unroll
            for (int j = 1; j < 8; ++j) fr = (i == j) ? inv_freq[j] : fr;
            const double ang = (double)P.pos[t] * fr;
            double s, c; sincos_d(ang, s, c);
            COS[e] = (float)c; SIN[e] = (float)s;
        }
    }
    convert_items(P, scr, 0, P.n_items_p0, gw, NGW, lane);
}

__device__ __forceinline__ float log_sigmoid_f(float z) { return (z >= 0.f) ? -log1pf(__expf(-z)) : (z - log1pf(__expf(z))); }
__device__ __forceinline__ void hprep_phase(const Params& P, LAS unsigned char* lds, int wave, int lane) {
    LAS float* SC1 = (LAS float*)lds; LAS float* SH = SC1 + DM; LAS float* WF = SH + DM;
    const float* mod = (const float*)(P.ws + WS_MOD);
    for (int i = threadIdx.x; i < DM; i += NTHR) { SH[i] = mod[i]; SC1[i] = 1.0f + mod[DM + i]; }
    for (int i = threadIdx.x; i < DM * 8; i += NTHR) WF[(i & 7) * DM + (i >> 3)] = P.w_in_ab[(size_t)(i >> 3) * EVEN_IN + 3 * FW + (i & 7)];
    __syncthreads();
    bf16* H = (bf16*)(P.ws + WS_H); float* LOGF = (float*)(P.ws + WS_LOGF);
    const int gw = blockIdx.x * NWAVES + wave, NGW = gridDim.x * NWAVES;
    for (int m = gw; m < M; m += NGW) {
        const f32x4* xr = (const f32x4*)(P.x + (size_t)m * DM) + lane;
        float fl[8];
#pragma unroll
        for (int j = 0; j < 8; ++j) fl[j] = 0.f;
        unsigned long long* o8 = (unsigned long long*)(H + (size_t)m * DM) + lane;
        f32x4 xv[8];
#pragma unroll
        for (int j = 0; j < 8; ++j) xv[j] = xr[64 * j];
#pragma unroll 2
        for (int j = 0; j < 8; ++j) {
            f32x4 v = xv[j];
            const f32x4 s1 = *(const LAS f32x4*)(SC1 + 4 * lane + 256 * j), sh = *(const LAS f32x4*)(SH + 4 * lane + 256 * j);
            v = v * s1 + sh;
            o8[64 * j] = (unsigned long long)pk2(v[0], v[1]) | ((unsigned long long)pk2(v[2], v[3]) << 32);
#pragma unroll
            for (int jf = 0; jf < 8; ++jf) {
                const f32x4 w = *(const LAS f32x4*)(WF + jf * DM + 4 * lane + 256 * j);
                fl[jf] += (v[0] * w[0] + v[1] * w[1]) + (v[2] * w[2] + v[3] * w[3]);
            }
        }
#pragma unroll
        for (int j = 0; j < 8; ++j) fl[j] = wave_sum(fl[j]);
        if (lane < 8) {
            float z = fl[0];
#pragma unroll
            for (int j = 1; j < 8; ++j) z = (lane == j) ? fl[j] : z;
            z += P.b_forget[lane];
            LOGF[(size_t)lane * M + m] = log_sigmoid_f(z);
        }
    }
    __syncthreads();
}

__device__ __forceinline__ void cumsum_phase(const Params& P, LAS unsigned char* lds, int wave, int lane) {
    const float* LOGF = (const float*)(P.ws + WS_LOGF); float* F = (float*)(P.ws + WS_F);
    LAS double* WT = (LAS double*)lds;
    for (int head = blockIdx.x; head < 8; head += gridDim.x) {
        const int t0 = threadIdx.x * 32;
        f32x4 lv[8];
#pragma unroll
        for (int i = 0; i < 8; ++i) lv[i] = *(const f32x4*)(LOGF + (size_t)head * M + t0 + 4 * i);
        double loc = 0.0;
#pragma unroll
        for (int i = 0; i < 8; ++i) loc += ((double)lv[i][0] + (double)lv[i][1]) + ((double)lv[i][2] + (double)lv[i][3]);
        double sc = loc;
#pragma unroll
        for (int o = 1; o < 64; o <<= 1) { const double n = __shfl_up(sc, o); if (lane >= o) sc += n; }
        if (lane == 63) WT[wave] = sc;
        __syncthreads();
        double base = sc - loc;
#pragma unroll
        for (int w = 0; w < NWAVES; ++w) base += (w < wave) ? WT[w] : 0.0;
        double run = base;
#pragma unroll
        for (int i = 0; i < 8; ++i) { f32x4 o;
#pragma unroll
            for (int e = 0; e < 4; ++e) { run += (double)lv[i][e]; o[e] = (float)run; }
            *(f32x4*)(F + (size_t)head * M + t0 + 4 * i) = o; }
        __syncthreads();
    }
}

__device__ __forceinline__ void ln_phase(float* T, const float* g, const float* b, const float* sh, const float* sc, bf16* H, LAS unsigned char* lds, int wave, int lane) {
    LAS float* G = (LAS float*)lds; LAS float* B = G + DM; LAS float* SC1 = B + DM; LAS float* SH = SC1 + DM;
    for (int i = threadIdx.x; i < DM; i += NTHR) { G[i] = g[i]; B[i] = b[i]; SC1[i] = sc ? 1.0f + sc[i] : 1.0f; SH[i] = sh ? sh[i] : 0.f; }
    __syncthreads();
    const int gw = blockIdx.x * NWAVES + wave, NGW = gridDim.x * NWAVES;
    for (int m = gw; m < M; m += NGW) {
        f32x4* xr = (f32x4*)(T + (size_t)m * DM) + lane;
        f32x4 v[8]; float s = 0.f;
#pragma unroll
        for (int j = 0; j < 8; ++j) { v[j] = xr[64 * j]; s += (v[j][0] + v[j][1]) + (v[j][2] + v[j][3]); }
        const float mean = wave_sum(s) * (1.f / DM); float s2 = 0.f;
#pragma unroll
        for (int j = 0; j < 8; ++j) { v[j] = v[j] - mean; s2 += (v[j][0] * v[j][0] + v[j][1] * v[j][1]) + (v[j][2] * v[j][2] + v[j][3] * v[j][3]); }
        const float rstd = 1.f / sqrtf(wave_sum(s2) * (1.f / DM) + LN_EPS);
#pragma unroll
        for (int j = 0; j < 8; ++j) {
            const f32x4 gg = *(const LAS f32x4*)(G + 4 * lane + 256 * j), bb = *(const LAS f32x4*)(B + 4 * lane + 256 * j);
            const f32x4 y = v[j] * rstd * gg + bb;
            xr[64 * j] = y;
            if (H) {
                const f32x4 s1 = *(const LAS f32x4*)(SC1 + 4 * lane + 256 * j), hh = *(const LAS f32x4*)(SH + 4 * lane + 256 * j);
                const f32x4 h = y * s1 + hh;
                ((unsigned long long*)(H + (size_t)m * DM) + lane)[64 * j] = (unsigned long long)pk2(h[0], h[1]) | ((unsigned long long)pk2(h[2], h[3]) << 32);
            }
        }
    }
    __syncthreads();
}

__device__ __forceinline__ void ln_apply_phase(const float* T, const float* stat, const float* g, const float* b, const float* sh, const float* sc, bf16* H, float* OUT,
                                               LAS unsigned char* lds, int wave, int lane) {
    LAS float* A = (LAS float*)lds; LAS float* B = A + DM;
    for (int i = threadIdx.x; i < DM; i += NTHR) { const float s1 = sc ? 1.0f + sc[i] : 1.0f; A[i] = g[i] * s1; B[i] = b[i] * s1 + (sh ? sh[i] : 0.f); }
    __syncthreads();
    const int gw = blockIdx.x * NWAVES + wave, NGW = gridDim.x * NWAVES;
    f32x4 av[8], bv[8];
#pragma unroll
    for (int j = 0; j < 8; ++j) { av[j] = *(const LAS f32x4*)(A + 4 * lane + 256 * j); bv[j] = *(const LAS f32x4*)(B + 4 * lane + 256 * j); }
#pragma unroll 2
    for (int m = gw; m < M; m += NGW) {
        const f32x4* xr = (const f32x4*)(T + (size_t)m * DM) + lane;
        f32x4 v[8];
#pragma unroll
        for (int j = 0; j < 8; ++j) v[j] = xr[64 * j];
        const float s1 = stat[2 * m], s2 = stat[2 * m + 1];
        const float mean = s1 * (1.0f / DM), var = s2 * (1.0f / DM) - mean * mean, rstd = 1.0f / sqrtf(var + LN_EPS);
#pragma unroll
        for (int j = 0; j < 8; ++j) {
            const f32x4 y = (v[j] - mean) * rstd * av[j] + bv[j];
            if (H) ((unsigned long long*)(H + (size_t)m * DM) + lane)[64 * j] = (unsigned long long)pk2(y[0], y[1]) | ((unsigned long long)pk2(y[2], y[3]) << 32);
            if (OUT) ((f32x4*)(OUT + (size_t)m * DM) + lane)[64 * j] = y;
        }
    }
    __syncthreads();
}

template <int D> struct AttnL { static constexpr int KP = D * 2 + 16, VP = 144, KBYTES = 64 * KP, VBYTES = D * VP, BIAS_OFF = KBYTES + VBYTES, BUF = BIAS_OFF + 256; };
__device__ __forceinline__ unsigned cvtpk(float lo, float hi) { unsigned r; asm volatile("v_cvt_pk_bf16_f32 %0, %1, %2" : "=v"(r) : "v"(lo), "v"(hi)); return r; }

#ifndef ATT_KDB
#define ATT_KDB 0
#endif
#ifndef ATT_VDB
#define ATT_VDB 0
#endif
template <int D, bool BIAS, bool NOMAX>
__device__ __forceinline__ void attn_tile(const LAS unsigned char* buf, const bf16x8 (&Qf)[D / 16], f32x16 (&o)[D / 32], float& m, float& l, float rowc, int dq, unsigned W, bool need_mask, int lane) {
    typedef AttnL<D> L;
    const int r32 = lane & 31, hh = lane >> 5;
    constexpr int GPB = (D / 16) / 4, NKG = 2 * GPB;
    constexpr int NDB = D / 32;
    f32x16 p[2];
    bf16x8 kf[2][4];
    const LAS unsigned char* kbase = buf + r32 * L::KP + 16 * hh;
#define AT_KLOAD(gi, dst) do { _Pragma("unroll") for (int j_ = 0; j_ < 4; ++j_) \
        dst[j_] = *(const LAS bf16x8*)(kbase + (32 * ((gi) / GPB)) * L::KP + (4 * ((gi) % GPB) + j_) * 32); } while (0)
#if ATT_KDB
    AT_KLOAD(0, kf[0]);
#endif
#pragma unroll
    for (int b = 0; b < 2; ++b) {
        if (BIAS) {
#pragma unroll
            for (int g = 0; g < 4; ++g) { const f32x4 bv = *(const LAS f32x4*)(buf + L::BIAS_OFF + (32 * b + 8 * g + 4 * hh) * 4);
                p[b][4 * g + 0] = bv[0]; p[b][4 * g + 1] = bv[1]; p[b][4 * g + 2] = bv[2]; p[b][4 * g + 3] = bv[3]; }
        } else {
#pragma unroll
            for (int r = 0; r < 16; ++r) p[b][r] = 0.f;
        }
    }
    __builtin_amdgcn_sched_barrier(0);
#pragma unroll
    for (int gi = 0; gi < NKG; ++gi) {
#if ATT_KDB
        if (gi + 1 < NKG) AT_KLOAD(gi + 1, kf[(gi + 1) & 1]);
#else
        AT_KLOAD(gi, kf[gi & 1]);
#endif
        __builtin_amdgcn_sched_barrier(0);
#pragma unroll
        for (int j = 0; j < 4; ++j) p[gi / GPB] = __builtin_amdgcn_mfma_f32_32x32x16_bf16(kf[gi & 1][j], Qf[4 * (gi % GPB) + j], p[gi / GPB], 0, 0, 0);
        __builtin_amdgcn_sched_barrier(0);
    }
#undef AT_KLOAD
    u32x4 vf[2][NDB];
    const LAS unsigned char* vbase = buf + L::KBYTES + r32 * L::VP + 8 * hh;
#define AT_VLOAD(gi, dst) do { _Pragma("unroll") for (int db_ = 0; db_ < NDB; ++db_) { \
        const LAS unsigned char* vp_ = vbase + (32 * db_) * L::VP + (gi) * 32; \
        const u32x2 lo_ = *(const LAS u32x2*)vp_, hi_ = *(const LAS u32x2*)(vp_ + 16); \
        dst[db_].x = lo_.x; dst[db_].y = lo_.y; dst[db_].z = hi_.x; dst[db_].w = hi_.y; } } while (0)
#if ATT_VDB
    AT_VLOAD(0, vf[0]);
#endif
    if (need_mask) {
        const float NEG = -__builtin_inff();
#pragma unroll
        for (int b = 0; b < 2; ++b)
#pragma unroll
            for (int r = 0; r < 16; ++r) { const int krel = 32 * b + (r & 3) + 8 * (r >> 2); if ((unsigned)(dq - krel) >= W) p[b][r] = NEG; }
    }
    if (NOMAX) {
        float rs = 0.f;
#pragma unroll
        for (int b = 0; b < 2; ++b)
#pragma unroll
            for (int r = 0; r < 16; ++r) { p[b][r] = __builtin_amdgcn_exp2f(p[b][r] + rowc); rs += p[b][r]; }
        l += rs;
    } else {
    float mx = p[0][0];
#pragma unroll
    for (int r = 1; r < 16; ++r) mx = fmaxf(mx, p[0][r]);
#pragma unroll
    for (int r = 0; r < 16; ++r) mx = fmaxf(mx, p[1][r]);
    mx = fmaxf(mx, __shfl_xor(mx, 32));
    const float mn = fmaxf(m, mx);
    const float alpha = __builtin_amdgcn_exp2f(m - mn);
    m = mn;
    float rs = 0.f;
#pragma unroll
    for (int b = 0; b < 2; ++b)
#pragma unroll
        for (int r = 0; r < 16; ++r) { p[b][r] = __builtin_amdgcn_exp2f(p[b][r] - mn); rs += p[b][r]; }
    l = l * alpha + rs;
#pragma unroll
    for (int db = 0; db < NDB; ++db) o[db] = o[db] * alpha;
    }
    __builtin_amdgcn_sched_barrier(0);
#pragma unroll
    for (int gi = 0; gi < 4; ++gi) {
        const int b = gi >> 1, sx = gi & 1;
#if ATT_VDB
        if (gi + 1 < 4) AT_VLOAD(gi + 1, vf[(gi + 1) & 1]);
#else
        AT_VLOAD(gi, vf[gi & 1]);
#endif
        u32x4 pw; pw.x = cvtpk(p[b][8 * sx + 0], p[b][8 * sx + 1]); pw.y = cvtpk(p[b][8 * sx + 2], p[b][8 * sx + 3]); pw.z = cvtpk(p[b][8 * sx + 4], p[b][8 * sx + 5]); pw.w = cvtpk(p[b][8 * sx + 6], p[b][8 * sx + 7]);
        const bf16x8 pf = __builtin_bit_cast(bf16x8, pw);
        __builtin_amdgcn_sched_barrier(0);
#pragma unroll
        for (int db = 0; db < NDB; ++db) o[db] = __builtin_amdgcn_mfma_f32_32x32x16_bf16(__builtin_bit_cast(bf16x8, vf[gi & 1][db]), pf, o[db], 0, 0, 0);
        __builtin_amdgcn_sched_barrier(0);
    }
#undef AT_VLOAD
}

template <int D, bool BIAS, bool NOMAX, bool GQA = false>
__device__ __forceinline__ void attn_unit(LAS unsigned char* lds, const bf16* Qp, int ldq, const bf16* Kp, int ldk, const bf16* Vt, const float* Fh, bf16* Op, int ldo,
                                          int q0, int t_lo, int t_hi, unsigned W, float m_init, float l_init, float cbound, int wave, int lane) {
    typedef AttnL<D> L;
    constexpr int KCH = D / 64;
    const int tid = threadIdx.x, r32 = lane & 31, hh = lane >> 5;
    const int qrow0 = GQA ? q0 : q0 + 32 * wave;
    if (GQA) { Qp += wave * D; Op += wave * D; }
    bf16x8 Qf[D / 16];
#pragma unroll
    for (int ks = 0; ks < D / 16; ++ks) Qf[ks] = *(const bf16x8*)(Qp + (size_t)(qrow0 + r32) * ldq + 16 * ks + 8 * hh);
    f32x16 o[D / 32];
#pragma unroll
    for (int db = 0; db < D / 32; ++db)
#pragma unroll
        for (int r = 0; r < 16; ++r) o[db][r] = 0.f;
    float m = m_init, l = (hh == 0) ? l_init : 0.f;
    float rowc = 0.f;
    if (NOMAX) rowc = Fh[qrow0 + r32] * LOG2E - cbound;
    u32x4 kreg[KCH], vreg[KCH]; float breg = 0.f;
#define ATT_LOAD(t) do { const int kb_ = (t) * 64; \
        _Pragma("unroll") for (int i_ = 0; i_ < KCH; ++i_) { const int c_ = tid + 512 * i_; \
            { const int key_ = c_ / (D / 8), cc_ = c_ % (D / 8); kreg[i_] = *(const u32x4*)(Kp + (size_t)(kb_ + key_) * ldk + 8 * cc_); } \
            { const int d_ = c_ >> 3, kc_ = c_ & 7; vreg[i_] = *(const u32x4*)(Vt + (size_t)d_ * M + kb_ + 8 * kc_); } } \
        if (BIAS) { if (tid < 64) breg = Fh[kb_ + tid] * (-LOG2E); } } while (0)
#define ATT_STORE(bufp) do { \
        _Pragma("unroll") for (int i_ = 0; i_ < KCH; ++i_) { const int c_ = tid + 512 * i_; \
            { const int key_ = c_ / (D / 8), cc_ = c_ % (D / 8); *(LAS u32x4*)((bufp) + key_ * L::KP + cc_ * 16) = kreg[i_]; } \
            { const int d_ = c_ >> 3, kc_ = c_ & 7; *(LAS u32x4*)((bufp) + L::KBYTES + d_ * L::VP + kc_ * 16) = vreg[i_]; } } \
        if (BIAS) { if (tid < 64) *(LAS float*)((bufp) + L::BIAS_OFF + tid * 4) = breg; } } while (0)
    ATT_LOAD(t_lo);
    ATT_STORE(lds);
    __syncthreads();
    for (int t = t_lo; t < t_hi; ++t) {
        LAS unsigned char* cur = lds + ((t - t_lo) & 1) * L::BUF;
        LAS unsigned char* nxt = lds + (((t - t_lo) & 1) ^ 1) * L::BUF;
        if (t + 1 < t_hi) ATT_LOAD(t + 1);
        const int kb = t * 64;
        const long long lo_need = (long long)qrow0 - (long long)(W - 1u);
        const bool active = (kb <= qrow0 + 31) && ((long long)kb + 63 >= lo_need);
        if (active) {
            const bool full = (kb + 63 <= qrow0) && ((long long)kb >= (long long)qrow0 + 31 - (long long)(W - 1u));
            attn_tile<D, BIAS, NOMAX>(cur, Qf, o, m, l, rowc, (qrow0 + r32) - kb - 4 * hh, W, !full, lane);
        }
        if (t + 1 < t_hi) ATT_STORE(nxt);
        __syncthreads();
    }
#undef ATT_LOAD
#undef ATT_STORE
    const float lt = l + __shfl_xor(l, 32);
    const float inv = 1.0f / lt;
    bf16* orow = Op + (size_t)(qrow0 + r32) * ldo;
#pragma unroll
    for (int db = 0; db < D / 32; ++db)
#pragma unroll
        for (int g = 0; g < 4; ++g) {
            u32x2 w; w.x = cvtpk(o[db][4 * g + 0] * inv, o[db][4 * g + 1] * inv); w.y = cvtpk(o[db][4 * g + 2] * inv, o[db][4 * g + 3] * inv);
            *(u32x2*)(orow + 32 * db + 8 * g + 4 * hh) = w;
        }
}

__device__ __forceinline__ void fox_norm_phase(const Params& P, int wave, int lane) {
    const bf16* Q = (const bf16*)(P.ws + WS_Q); const bf16* K = (const bf16*)(P.ws + WS_K);
    unsigned* ctl = (unsigned*)(P.ws + WS_MOD);
    const int gw = blockIdx.x * NWAVES + wave, NGW = gridDim.x * NWAVES;
    for (int it = gw; it < 2 * 8 * 256; it += NGW) {
        const int isk = it & 1, head = (it >> 1) & 7, tile = it >> 4;
        const bf16* src = (isk ? K : Q) + (size_t)tile * 64 * FW + head * 128;
        float mx = 0.f;
#pragma unroll 4
        for (int i = 0; i < 16; ++i) {
            const u32x4 w = *(const u32x4*)(src + (size_t)(4 * i + (lane >> 4)) * FW + 8 * (lane & 15));
            float a = bflo(w.x) * bflo(w.x) + bfhi(w.x) * bfhi(w.x); a += bflo(w.y) * bflo(w.y) + bfhi(w.y) * bfhi(w.y);
            a += bflo(w.z) * bflo(w.z) + bfhi(w.z) * bfhi(w.z); a += bflo(w.w) * bflo(w.w) + bfhi(w.w) * bfhi(w.w);
            a += __shfl_xor(a, 1); a += __shfl_xor(a, 2); a += __shfl_xor(a, 4); a += __shfl_xor(a, 8);
            mx = fmaxf(mx, a);
        }
        mx = fmaxf(mx, __shfl_xor(mx, 16)); mx = fmaxf(mx, __shfl_xor(mx, 32));
        if (lane == 0) atomicMax(ctl + (isk ? CW_KMAX2 + head : CW_QN2 + head * 64 + (tile >> 2)), __float_as_uint(mx));
    }
}
__device__ __forceinline__ void fox_phase(const Params& P, LAS unsigned char* lds, int wave, int lane) {
    const bf16* Q = (const bf16*)(P.ws + WS_Q); const bf16* K = (const bf16*)(P.ws + WS_K); const bf16* VT = (const bf16*)(P.ws + WS_VT);
    const float* F = (const float*)(P.ws + WS_F); bf16* MIX = (bf16*)(P.ws + WS_MIX);
    const unsigned* ctl = (const unsigned*)(P.ws + WS_MOD);
    for (int it = (int)VCU(lds); it < 256; it += gridDim.x) {
        const int head = it & 7, pi = it >> 3;
#pragma unroll 1
        for (int half = 0; half < 2; ++half) {
            const int qb = half == 0 ? 63 - pi : pi;
            const float* Fh = F + (size_t)head * M;
            const float kn = sqrtf(__uint_as_float(ctl[CW_KMAX2 + head])), qn = sqrtf(__uint_as_float(ctl[CW_QN2 + head * 64 + qb]));
            const float bound = 2.0f * qn * kn * 1.01f + 2.0f;
            const int j = threadIdx.x;
            const bool skippable = (j < 4 * qb) && (bound + (Fh[qb * 256] - Fh[j < 256 ? 64 * j + 63 : 63]) * LOG2E < -152.0f);
            const int t_lo = __syncthreads_count(skippable ? 1 : 0);
            attn_unit<128, true, true>(lds, Q + head * 128, FW, K + head * 128, FW, VT + (size_t)head * 128 * M, Fh, MIX + head * 128, DM,
                                       qb * 256, t_lo, 4 * qb + 4, 0x7fffffffu, -1e30f, 0.f, fminf(0.5f * bound, 55.0f), wave, lane);
        }
    }
}

__device__ __forceinline__ void swa_phase(const Params& P, LAS unsigned char* lds, int wave, int lane) {
    const bf16* Q = (const bf16*)(P.ws + WS_Q2); const bf16* K = (const bf16*)(P.ws + WS_K2); const bf16* VT = (const bf16*)(P.ws + WS_VT2); bf16* O = (bf16*)(P.ws + WS_MIX);
    for (int it = (int)VCU(lds); it < 2048; it += gridDim.x) {
        const int kv = (it & 7) >> 1, rb = ((it & 1) << 8) | (it >> 3);
        const int q0 = rb * 32;
        const float sinkl = P.sinks[kv * 8 + wave] * LOG2E;
        const int t_lo = (q0 - 127) < 0 ? 0 : ((q0 - 127) >> 6), t_hi = (q0 >> 6) + 1;
        attn_unit<64, false, false, true>(lds, Q + kv * 512, DM, K + kv * 64, KVW, VT + (size_t)kv * 64 * M, nullptr, O + kv * 512, DM, q0, t_lo, t_hi, 128u, sinkl, 1.0f, 0.f, wave, lane);
    }
}

constexpr int SSM_SUB = 256, SSM_NSUB = M / SSM_SUB  , SSM_STEPS = SSM_SUB / 16;
struct SsmC2 { f32x2 lb[2]; f32x2 lbR[2]; bf16x8 Bh[4], Bl[4]; };
__device__ __forceinline__ void ssm_consts2(const Params& P, int g, int lane, SsmC2& C) {
    const int p5 = lane & 31, hh = lane >> 5;
    const double dtf = exp((double)P.log_dt[g]);
#pragma unroll
    for (int par = 0; par < 2; ++par) {
        const int st = 2 * p5 + par;
        const double lr = (double)P.lam_re[g * 64 + st], li = (double)P.lam_im[g * 64 + st];
        const double mag = exp(lr * dtf);
        double s, c; sincos_d(li * dtf, s, c);
        const double lbr = mag * c, lbi = mag * s;
        const double den = lr * lr + li * li, nr = lbr - 1.0;
        const double qr = (nr * lr + lbi * li) / den, qi = (lbi * lr - nr * li) / den;
        C.lb[par] = (f32x2){(float)lbr, (float)lbi};
        const double magR = exp(lr * dtf * SSM_SUB);
        double sR, cR; sincos_d(li * dtf * SSM_SUB, sR, cR);
        C.lbR[par] = (f32x2){(float)(magR * cR), (float)(magR * sR)};
        const f32x4* br = (const f32x4*)(P.b_re + (size_t)(g * 64 + st) * 16 + 8 * hh); const f32x4* bi = (const f32x4*)(P.b_im + (size_t)(g * 64 + st) * 16 + 8 * hh);
        float vre[8], vim[8];
#pragma unroll
        for (int j = 0; j < 2; ++j) { const f32x4 r = br[j], i = bi[j];
#pragma unroll
            for (int e = 0; e < 4; ++e) { const double rr = (double)r[e], ii = (double)i[e]; vre[4 * j + e] = (float)(qr * rr - qi * ii); vim[4 * j + e] = (float)(qr * ii + qi * rr); } }
        u32x4 hr, lr4, hi4, li4;
#pragma unroll
        for (int e = 0; e < 4; ++e) {
            const unsigned wr = cvtpk(vre[2 * e], vre[2 * e + 1]); hr[e] = wr; lr4[e] = cvtpk(vre[2 * e] - bflo(wr), vre[2 * e + 1] - bfhi(wr));
            const unsigned wi = cvtpk(vim[2 * e], vim[2 * e + 1]); hi4[e] = wi; li4[e] = cvtpk(vim[2 * e] - bflo(wi), vim[2 * e + 1] - bfhi(wi));
        }
        C.Bh[par] = __builtin_bit_cast(bf16x8, hr); C.Bl[par] = __builtin_bit_cast(bf16x8, lr4);
        C.Bh[2 + par] = __builtin_bit_cast(bf16x8, hi4); C.Bl[2 + par] = __builtin_bit_cast(bf16x8, li4);
    }
}
__device__ __forceinline__ void ssm_bu(const SsmC2& C, const bf16x8 ua, f32x16 (&acc)[4]) {
#pragma unroll
    for (int b = 0; b < 4; ++b) {
#pragma unroll
        for (int r = 0; r < 16; ++r) acc[b][r] = 0.f;
        acc[b] = __builtin_amdgcn_mfma_f32_32x32x16_bf16(ua, C.Bh[b], acc[b], 0, 0, 0);
        acc[b] = __builtin_amdgcn_mfma_f32_32x32x16_bf16(ua, C.Bl[b], acc[b], 0, 0, 0);
    }
}
__device__ __forceinline__ void ssm_upd(const f32x2 lb, f32x2& x, float bre, float bim) {
    const f32x2 nx = {__builtin_fmaf(lb.x, x.x, __builtin_fmaf(-lb.y, x.y, bre)), __builtin_fmaf(lb.x, x.y, __builtin_fmaf(lb.y, x.x, bim))};
    x = nx;
}
__device__ __forceinline__ void ssm_pass1(const Params& P, LAS unsigned char* lds, int wave, int lane) {
    const bf16* U = (const bf16*)(P.ws + WS_U); f32x4* E = (f32x4*)(P.ws + WS_E);
    const int gw = __builtin_amdgcn_readfirstlane(blockIdx.x * NWAVES + wave), NGW = gridDim.x * NWAVES;
    const int p5 = lane & 31, hh = lane >> 5;
    const int asr = (p5 >> 2) & 1, ajj = (p5 & 3) + 4 * (p5 >> 3);
    for (int it = gw; it < 64 * (SSM_NSUB / 2); it += NGW) {
        const int g = it & 63, run = it >> 6;
        const bf16* up = U + ((size_t)(run * 2 + asr) * SSM_SUB + 8 * ajj) * FW + g * 16 + 8 * hh;
        bf16x8 ua[8];
#pragma unroll
        for (int ks = 0; ks < 8; ++ks) ua[ks] = *(const bf16x8*)(up + (size_t)ks * FW);
        const double dtf = exp((double)P.log_dt[g]);
        f32x2 xe[2] = {{0.f, 0.f}, {0.f, 0.f}};
#pragma unroll
        for (int par = 0; par < 2; ++par) {
            const int st = 2 * p5 + par;
            const double lr = (double)P.lam_re[g * 64 + st], li = (double)P.lam_im[g * 64 + st];
            const double mag = exp(lr * dtf);
            double s, c; sincos_d(li * dtf, s, c);
            const double lbr = mag * c, lbi = mag * s;
            const double den = lr * lr + li * li, nr = lbr - 1.0;
            const double qr = (nr * lr + lbi * li) / den, qi = (lbi * lr - nr * li) / den;
            const f32x4* br = (const f32x4*)(P.b_re + (size_t)(g * 64 + st) * 16 + 8 * hh); const f32x4* bi = (const f32x4*)(P.b_im + (size_t)(g * 64 + st) * 16 + 8 * hh);
            float vre[8], vim[8];
#pragma unroll
            for (int j = 0; j < 2; ++j) { const f32x4 r = br[j], i = bi[j];
#pragma unroll
                for (int e = 0; e < 4; ++e) { const double rr = (double)r[e], ii = (double)i[e]; vre[4 * j + e] = (float)(qr * rr - qi * ii); vim[4 * j + e] = (float)(qr * ii + qi * rr); } }
            const float lx = (float)lbr, ly = (float)lbi;
            float wx = 1.f, wy = 0.f;
            bf16x8 Wre[8], Wim[8];
#pragma unroll
            for (int ks = 7; ks >= 0; --ks) {
                u32x4 fr4, fi4;
#pragma unroll
                for (int e = 0; e < 4; ++e) {
                    fr4[e] = cvtpk(wx * vre[2 * e] - wy * vim[2 * e], wx * vre[2 * e + 1] - wy * vim[2 * e + 1]);
                    fi4[e] = cvtpk(wx * vim[2 * e] + wy * vre[2 * e], wx * vim[2 * e + 1] + wy * vre[2 * e + 1]);
                }
                Wre[ks] = __builtin_bit_cast(bf16x8, fr4); Wim[ks] = __builtin_bit_cast(bf16x8, fi4);
                const float nx = wx * lx - wy * ly, ny = wx * ly + wy * lx; wx = nx; wy = ny;
            }
            const f32x2 l8 = {wx, wy};
#pragma unroll
            for (int c2 = 0; c2 < 2; ++c2) {
                if (!(par == 0 && c2 == 0)) {
#pragma unroll
                    for (int ks = 0; ks < 8; ++ks) ua[ks] = *(const bf16x8*)(up + (size_t)(c2 * 128 + ks) * FW);
                }
                f32x16 are, aim;
#pragma unroll
                for (int r = 0; r < 16; ++r) { are[r] = 0.f; aim[r] = 0.f; }
#pragma unroll
                for (int ks = 0; ks < 8; ++ks) { are = __builtin_amdgcn_mfma_f32_32x32x16_bf16(ua[ks], Wre[ks], are, 0, 0, 0); aim = __builtin_amdgcn_mfma_f32_32x32x16_bf16(ua[ks], Wim[ks], aim, 0, 0, 0); }
#pragma unroll
                for (int r = 0; r < 16; ++r) ssm_upd(l8, xe[par], are[r], aim[r]);
            }
        }
        E[((size_t)(run * 2 + hh) * 64 + g) * 32 + p5] = (f32x4){xe[0].x, xe[0].y, xe[1].x, xe[1].y};
    }
}
__device__ __forceinline__ float sigmoid_f(float v) { return __builtin_amdgcn_rcpf(1.0f + __builtin_amdgcn_exp2f(-1.4426950408889634f * v)); }
__device__ __forceinline__ float gelu_tanh_f(float y) { const float z = 0.7978845608028654f * (y + 0.044715f * y * y * y); return y * sigmoid_f(2.0f * z); }
__device__ __forceinline__ void ssm_pass2(const Params& P, LAS unsigned char* lds, int wave, int lane) {
    const bf16* U = (const bf16*)(P.ws + WS_U); const f32x4* E = (const f32x4*)(P.ws + WS_E); bf16* S = (bf16*)(P.ws + WS_S);
    LAS unsigned char* XL = lds + wave * 8192;
    const int gw = __builtin_amdgcn_readfirstlane(blockIdx.x * NWAVES + wave), NGW = gridDim.x * NWAVES;
    const int p5 = lane & 31, hh = lane >> 5;
    const int ahh = (p5 >> 2) & 1, ar = (p5 & 3) + 4 * (p5 >> 3);
    const int h = lane & 15, tq = lane >> 4;
    for (int it = gw; it < 64 * (SSM_NSUB / 2); it += NGW) {
        const int g = it & 63, run = it >> 6;
        const bf16* up = U + ((size_t)(run * 2 + ahh) * SSM_SUB + ar) * FW + g * 16 + 8 * hh;
        bf16x8 u0 = *(const bf16x8*)up, u1 = *(const bf16x8*)(up + (size_t)16 * FW), u2 = *(const bf16x8*)(up + (size_t)32 * FW), u3 = *(const bf16x8*)(up + (size_t)48 * FW);
        SsmC2 C; ssm_consts2(P, g, lane, C);
        bf16x8 Cf[4];
#pragma unroll
        for (int ks = 0; ks < 4; ++ks) {
            const f32x4 cr = *(const f32x4*)(P.c_re + (size_t)(g * 16 + h) * 64 + 16 * ks + 4 * tq), ci = *(const f32x4*)(P.c_im + (size_t)(g * 16 + h) * 64 + 16 * ks + 4 * tq);
            u32x4 w; w.x = cvtpk(cr[0], -ci[0]); w.y = cvtpk(cr[1], -ci[1]); w.z = cvtpk(cr[2], -ci[2]); w.w = cvtpk(cr[3], -ci[3]);
            Cf[ks] = __builtin_bit_cast(bf16x8, w);
        }
        const float dsk = P.ssm_d[g * 16 + h];
        f32x2 x0 = {0.f, 0.f}, x1 = {0.f, 0.f};
        const int sr = 2 * run + hh;
#pragma unroll 8
        for (int rr = 0; rr < 2 * run + 1; ++rr) {
            const f32x4 e = E[((size_t)rr * 64 + g) * 32 + p5];
            if (rr < sr) { ssm_upd(C.lbR[0], x0, e[0], e[1]); ssm_upd(C.lbR[1], x1, e[2], e[3]); }
        }
        LAS unsigned char* wbase = XL + hh * 16 * 256 + (p5 & 1) * 8;
#pragma unroll 1
        for (int step = 0; step < SSM_STEPS; ++step) {
            const bf16x8 ua = u0; u0 = u1; u1 = u2; u2 = u3;
            if (step + 4 < SSM_STEPS) u3 = *(const bf16x8*)(up + (size_t)(step + 4) * 16 * FW);
            f32x16 acc[4]; ssm_bu(C, ua, acc);
#pragma unroll
            for (int r = 0; r < 16; ++r) {
                ssm_upd(C.lb[0], x0, acc[0][r], acc[2][r]); ssm_upd(C.lb[1], x1, acc[1][r], acc[3][r]);
                u32x2 w; w.x = cvtpk(x0.x, x0.y); w.y = cvtpk(x1.x, x1.y);
                *(LAS u32x2*)(wbase + r * 256 + (((p5 >> 1) ^ r) << 4)) = w;
            }
            asm volatile("s_waitcnt lgkmcnt(0)" ::: "memory");
#pragma unroll
            for (int rb = 0; rb < 2; ++rb) {
                f32x4 ya = {0.f, 0.f, 0.f, 0.f};
#pragma unroll
                for (int ks = 0; ks < 4; ++ks) {
                    const bf16x8 af = *(const LAS bf16x8*)(XL + (16 * rb + h) * 256 + (((4 * ks + tq) ^ h) << 4));
                    ya = __builtin_amdgcn_mfma_f32_16x16x32_bf16(af, Cf[ks], ya, 0, 0, 0);
                }
#pragma unroll
                for (int q = 0; q < 4; ++q) {
                    const size_t tok = (size_t)(run * 2 + rb) * SSM_SUB + step * 16 + 4 * tq + q;
                    const float uv = __builtin_bit_cast(float, (unsigned)U[tok * FW + g * 16 + h] << 16);
                    S[tok * FW + g * 16 + h] = (bf16)f2bf(gelu_tanh_f(ya[q] + dsk * uv));
                }
            }
            asm volatile("s_waitcnt lgkmcnt(0)" ::: "memory");
        }
    }
}
#define XB_TMO      128
#define XB_XCNT(j)  (256  + 64 * (j))
#define XB_XSUB(j)  (1280 + 64 * (j))
#define XB_XGEN(j)  (2304 + 64 * (j))
#define XB_TOP      3328
#define XB_TOPGEN   3392
#define XCD_BAR_WORDS 3456
#define XB_SPIN_CAP (1u << 23)

__device__ __forceinline__ unsigned xb_ld(unsigned* p)              { return __hip_atomic_load(p, __ATOMIC_RELAXED, __HIP_MEMORY_SCOPE_AGENT); }
__device__ __forceinline__ unsigned xb_add(unsigned* p, unsigned v) { return __hip_atomic_fetch_add(p, v, __ATOMIC_RELAXED, __HIP_MEMORY_SCOPE_AGENT); }
__device__ __forceinline__ unsigned xb_xcc_id() { return (unsigned)__builtin_amdgcn_s_getreg((3 << 11) | 20) & 0xFu; }
#define XB_SPIN(cond, bar) do { unsigned _sp = 0; while (cond) { __builtin_amdgcn_s_sleep(1); \
    if ((++_sp & 255u) == 0u) { if (xb_ld(&(bar)[XB_TMO])) break; if (_sp > XB_SPIN_CAP) { atomicAdd(&(bar)[XB_TMO], 1u); break; } } } } while (0)

struct XcdBarrier {
    unsigned* bar; unsigned x;
    volatile LAS unsigned* st;
};

__device__ __forceinline__ XcdBarrier xcd_barrier_post(unsigned* bar, volatile LAS unsigned* st) {
    XcdBarrier b; b.bar = bar; b.x = xb_xcc_id(); b.st = st;
    if (threadIdx.x == 0) st[3] = xb_add(&bar[XB_XCNT(b.x)], 1u);
    return b;
}
__device__ __forceinline__ void xcd_barrier_complete(unsigned* bar, unsigned x, unsigned& nloc, unsigned& nx) {
    const unsigned G = gridDim.x * gridDim.y * gridDim.z;
    unsigned sum, cnt, mine, sp = 0u;
    for (;;) {
        sum = 0u; cnt = 0u; mine = 0u;
#pragma unroll
        for (unsigned j = 0; j < 16; ++j) { const unsigned c = xb_ld(&bar[XB_XCNT(j)]); sum += c; cnt += (c > 0u) ? 1u : 0u; mine = (j == x) ? c : mine; }
        if (sum == G) break;
        __builtin_amdgcn_s_sleep(1);
        if ((++sp & 255u) == 0u) { if (xb_ld(&bar[XB_TMO])) break; if (sp > XB_SPIN_CAP) { atomicAdd(&bar[XB_TMO], 1u); break; } }
    }
    nloc = mine > 0u ? mine : 1u; nx = cnt > 0u ? cnt : 1u;
}

__device__ __forceinline__ void xcd_barrier(const XcdBarrier& b) {
    asm volatile("s_waitcnt vmcnt(0)" ::: "memory");
    __syncthreads();
    if (threadIdx.x == 0) {
        unsigned* bar = b.bar;
        __builtin_amdgcn_s_waitcnt(0);
        unsigned nloc = b.st[0], nx = b.st[1];
        if (nloc == 0u) { xcd_barrier_complete(bar, b.x, nloc, nx); b.st[0] = nloc; b.st[1] = nx; }
        const unsigned old = xb_add(&bar[XB_XSUB(b.x)], 1u);
        const unsigned gen = old / nloc;
        if (old + 1u == (gen + 1u) * nloc) {
            __builtin_amdgcn_fence(__ATOMIC_RELEASE, "agent");
            asm volatile("s_waitcnt vmcnt(0)" ::: "memory");
            const unsigned og = xb_add(&bar[XB_TOP], 1u);
            const unsigned tg = og / nx;
            if (og + 1u == (tg + 1u) * nx) xb_add(&bar[XB_TOPGEN], 1u);
            else XB_SPIN(xb_ld(&bar[XB_TOPGEN]) == tg, bar);
            __builtin_amdgcn_fence(__ATOMIC_ACQUIRE, "agent");
            xb_add(&bar[XB_XGEN(b.x)], 1u);
            asm volatile("s_waitcnt vmcnt(0)" ::: "memory");
        } else {
            XB_SPIN(xb_ld(&bar[XB_XGEN(b.x)]) == gen, bar);
            __builtin_amdgcn_fence(__ATOMIC_ACQUIRE, "agent");
            asm volatile("s_waitcnt vmcnt(0)" ::: "memory");
        }
    }
    __syncthreads();
}

__device__ __forceinline__ int opaque_lane(int lane) { asm volatile("" : "+v"(lane)); return lane; }
constexpr int CW_BAR = 28672;
#ifdef PROBE_SYNC2
#define GSYNC() do { xcd_barrier(bar); xcd_barrier(bar); } while (0)
#else
#define GSYNC() xcd_barrier(bar)
#endif
#ifndef PG8_SP2
#define PG8_SP2 true
#endif
#ifndef PG8_ALIGN
#define PG8_ALIGN true
#endif
template <class Epi>
__device__ __forceinline__ void run_gemm(LAS unsigned char* lds, const bf16* A, const bf16* Bt, int m, int n, int k, const Epi& E, int cshift) {
    pg8::Gemm g{A, Bt, m, n, k}; pg8::StaticOrder S; S.init(m, n, (int)gridDim.x, (int)((VCU(lds) + cshift) % gridDim.x));
    pg8::gemm_phase<Epi, pg8::StaticOrder, PG8_ALIGN, PG8_SP2>(lds, g, S, E);
}

template <class Epi>
__device__ __forceinline__ void run_gemm_panel(LAS unsigned char* lds, const bf16* A, const bf16* Bt, int k, const Epi& E) {
    pg8::Gemm g{A, Bt, M, DM, k}; pg8::PanelOrder S; S.init((int)VCU(lds));
    pg8::gemm_phase<Epi, pg8::PanelOrder, PG8_ALIGN, PG8_SP2>(lds, g, S, E);
}
__device__ __forceinline__ void ffn_part(const Params& P, const int layer, LAS unsigned char* lds, const XcdBarrier& bar, int wave, int lane) {
    unsigned char* ws = P.ws;
    const float* mod = (const float*)(ws + WS_MOD);
    const float* md = mod + layer * 12288;
    bf16* H = (bf16*)(ws + WS_H); bf16* MID = (bf16*)(ws + WS_MID); float* XA = P.out;
    float* STAT = (float*)(ws + WS_STAT); unsigned* PCNT = (unsigned*)(ws + WS_PCNT);
    const float* st_mix = STAT + (size_t)(2 * layer) * 2 * M; float* st_ffn = STAT + (size_t)(2 * layer + 1) * 2 * M;
    {
        pg8::EpiSwiglu E{MID, DFF};
        run_gemm(lds, H, (const bf16*)(ws + (layer == 0 ? WS_WGU0 : WS_WGU1)), M, 2 * DFF, DM, E, 0);
#ifdef PROBE_GU2
        if (layer == 0) run_gemm(lds, H, (const bf16*)(ws + (layer == 0 ? WS_WGU0 : WS_WGU1)), M, 2 * DFF, DM, E, 0);
#endif
    }
    GSYNC();
    if (layer == 0) {
        pg8::EpiResidLNF<true, false> E{XA, XA, md + 5 * DM, ALPHA, DM, st_mix, P.ln_mix_g, P.ln_mix_b, st_ffn, PCNT + 1 * 4096, P.ln_ffn_g, P.ln_ffn_b, mod + 12288, mod + 12288 + DM, H, nullptr};
        run_gemm_panel(lds, MID, (const bf16*)(ws + WS_WD0), DFF, E);
    } else {
        pg8::EpiResidLNF<true, true> E{XA, XA, md + 5 * DM, ALPHA, DM, st_mix, P.ln_mix_g + DM, P.ln_mix_b + DM, st_ffn, PCNT + 3 * 4096, P.ln_ffn_g + DM, P.ln_ffn_b + DM, nullptr, nullptr, nullptr, XA};
        run_gemm_panel(lds, MID, (const bf16*)(ws + WS_WD1), DFF, E);
    }
}

__global__ void __launch_bounds__(NTHR, 2) mega_fwd(Params P) {
    extern __shared__ __attribute__((aligned(16))) unsigned char lds_raw[];
    cg::grid_group grid = cg::this_grid();
    LAS unsigned char* lds = (LAS unsigned char*)lds_raw;
    const int tid = threadIdx.x, lane = tid & 63, wave = __builtin_amdgcn_readfirstlane(tid >> 6);
    unsigned char* ws = P.ws;
    const float* mod = (const float*)(ws + WS_MOD);
    bf16* H = (bf16*)(ws + WS_H); bf16* MIX = (bf16*)(ws + WS_MIX); bf16* MID = (bf16*)(ws + WS_MID);
    float* XA = P.out;

    if (tid < 4) ((LAS unsigned*)(lds + LDS_BARST))[tid] = 0u;
    __syncthreads();
    const XcdBarrier bar = xcd_barrier_post((unsigned*)(ws + WS_MOD) + CW_BAR, (volatile LAS unsigned*)(lds + LDS_BARST));
#ifndef SK_P0
    p0_prologue(P, lds, wave, opaque_lane(lane));
#endif
    GSYNC();
    if (P.out == nullptr) grid.sync();
    if (tid == 0) {
        volatile LAS unsigned* st = (volatile LAS unsigned*)(lds + LDS_BARST);
        const unsigned rank = st[3], xcc = bar.x; unsigned v = 0;
#pragma unroll
        for (unsigned j = 0; j < 16; ++j) { const unsigned c = xb_ld(&bar.bar[XB_XCNT(j)]); v += (c < rank ? c : rank) + ((j < xcc && c > rank) ? 1u : 0u); }
#ifdef NO_VCU
        v = blockIdx.x;
#endif
        st[2] = v;
    }
    __syncthreads();
#ifndef SK_HPREP
    hprep_phase(P, lds, wave, opaque_lane(lane));
#if defined(PROBE_MISC2) || defined(PROBE_HPREP2)
    hprep_phase(P, lds, wave, opaque_lane(lane));
#endif
#endif
    GSYNC();

#ifndef SK_CUMSUM
    cumsum_phase(P, lds, wave, opaque_lane(lane));
#endif
    {
        pg8::EpiBf16<0> E{(bf16*)(ws + WS_Q), FW, nullptr, FW, (size_t)M * FW, 0.08838834764831845f * LOG2E};
        run_gemm(lds, H, (const bf16*)(ws + WS_W1T), M, 3 * FW, DM, E, 0);
    }
    {
        pg8::EpiBf16<0> E{(bf16*)(ws + WS_VT), M, nullptr, 0, 0, 1.0f};
        run_gemm(lds, (const bf16*)(ws + WS_WVT), H, FW, M, DM, E, 0);
    }
    GSYNC();
    fox_norm_phase(P, wave, opaque_lane(lane));
#ifndef SK_SSM1
    ssm_pass1(P, lds, wave, opaque_lane(lane));
#endif
#if defined(PROBE_MISC2) || defined(PROBE_P3A2)
    fox_norm_phase(P, wave, opaque_lane(lane)); ssm_pass1(P, lds, wave, opaque_lane(lane));
#endif
#ifdef PROBE_SSM1ONLY
    ssm_pass1(P, lds, wave, opaque_lane(lane));
#endif
#ifdef PROBE_CONSTS
    ssm_probe_consts(P, wave, opaque_lane(lane));
#endif
#ifdef PROBE_NORM2
    fox_norm_phase(P, wave, opaque_lane(lane));
#endif
    GSYNC();
#ifndef SK_FOX
    fox_phase(P, lds, wave, opaque_lane(lane));
#ifdef PROBE_FOX2
    __syncthreads(); fox_phase(P, lds, wave, opaque_lane(lane));
#endif
#endif
    __syncthreads();
#ifndef SK_SSM2
    ssm_pass2(P, lds, wave, opaque_lane(lane));
#ifdef PROBE_SSM2
    ssm_pass1(P, lds, wave, opaque_lane(lane)); ssm_pass2(P, lds, wave, opaque_lane(lane));
#endif
#endif
    GSYNC();
    {
        pg8::EpiGlu E{(const bf16*)(ws + WS_S), FW, P.b_glu, MIX, DM, FW};
        run_gemm(lds, (const bf16*)(ws + WS_S), (const bf16*)(ws + WS_WGLU), M, FW, FW, E, 0);
    }
    GSYNC();
    {
        pg8::EpiResidLNF<false, false> E{P.x, XA, mod + 2 * DM, ALPHA, DM, nullptr, nullptr, nullptr, (float*)(ws + WS_STAT), (unsigned*)(ws + WS_PCNT), P.ln_mix_g, P.ln_mix_b, mod + 3 * DM, mod + 4 * DM, H, nullptr};
        run_gemm_panel(lds, MIX, (const bf16*)(ws + WS_WOUT), DM, E);
    }
    GSYNC();
    ffn_part(P, 0, lds, bar, wave, lane);
    GSYNC();
    {
        const float* md = mod + 12288;
        {
            pg8::EpiQKRot E{(bf16*)(ws + WS_Q2), DM, 8, 0.125f * LOG2E, (bf16*)(ws + WS_K2), KVW, (const float*)(ws + WS_COS), (const float*)(ws + WS_SIN)};
            run_gemm(lds, H, (const bf16*)(ws + WS_WC1T), M, DM + KVW, DM, E, 0);
        }
        {
            pg8::EpiBf16<0> E{(bf16*)(ws + WS_VT2), M, nullptr, 0, 0, 1.0f};
            run_gemm(lds, (const bf16*)(ws + WS_WCVT), H, KVW, M, DM, E, 192);
        }
        { const unsigned v = VCU(lds); if (v >= 128u) convert_items(P, (LAS float*)(lds + wave * 16384), P.n_items_p0, P.n_items, (int)(v - 128u) * NWAVES + wave, 128 * NWAVES, opaque_lane(lane)); }
        GSYNC();
#ifndef SK_SWA
        swa_phase(P, lds, wave, opaque_lane(lane));
#if defined(PROBE_SWA2) || defined(PROBE_MISC2)
        swa_phase(P, lds, wave, opaque_lane(lane));
#endif
#endif
        GSYNC();
        {
            pg8::EpiResidLNF<true, false> E{XA, XA, md + 2 * DM, ALPHA, DM, (const float*)(ws + WS_STAT) + 1 * 2 * M, P.ln_ffn_g, P.ln_ffn_b, (float*)(ws + WS_STAT) + 2 * 2 * M,
                                           (unsigned*)(ws + WS_PCNT) + 2 * 4096, P.ln_mix_g + DM, P.ln_mix_b + DM, md + 3 * DM, md + 4 * DM, H, nullptr};
            run_gemm_panel(lds, MIX, (const bf16*)(ws + WS_WOC), DM, E);
        }
        GSYNC();
    }
    ffn_part(P, 1, lds, bar, wave, lane);
}

static void add_td(Params& p, int& n, int& items, const float* src, bf16* dst, int ld, int K, int ncols, int mode, int row_off) {
    TDesc& d = p.td[n++]; d.src = src; d.dst = dst; d.ld = ld; d.K = K; d.ncols = ncols; d.mode = mode; d.row_off = row_off; d.first = items;
    items += (K / 64) * (ncols / 32);
}
extern "C" void kernel_launch(void* const* d_in, const int* in_sizes, int n_in, void* d_out, int out_size, void* d_ws, size_t ws_size, hipStream_t stream) {
    static int grid = 0;
    if (grid == 0) {
        if (n_in != 28 || in_sizes[0] != M * DM || out_size != M * DM || ws_size < WS_END) {
            fprintf(stderr, "kernel_launch: unexpected problem (n_in %d, in0 %d, out %d, ws %zu); nothing launched\n", n_in, n_in > 0 ? in_sizes[0] : -1, out_size, ws_size); grid = -1; return; }
        int dev = 0, cus = 0, per_cu = 0;
        (void)hipGetDevice(&dev);
        (void)hipDeviceGetAttribute(&cus, hipDeviceAttributeMultiprocessorCount, dev);
        if (hipFuncSetAttribute((const void*)mega_fwd, hipFuncAttributeMaxDynamicSharedMemorySize, LDS_BYTES) != hipSuccess) { fprintf(stderr, "kernel_launch: hipFuncSetAttribute failed\n"); grid = -1; return; }
        if (hipOccupancyMaxActiveBlocksPerMultiprocessor(&per_cu, (const void*)mega_fwd, NTHR, LDS_BYTES) != hipSuccess || per_cu < 1) { fprintf(stderr, "kernel_launch: occupancy query gives %d\n", per_cu); per_cu = 1; }
        (void)hipGetLastError();
        grid = cus * 1;
        if (grid != 256) { fprintf(stderr, "kernel_launch: this kernel's fused LayerNorm epilogues need a 256-workgroup grid (256 CUs); got %d\n", grid); grid = -1; return; }
        fprintf(stderr, "kernel_launch: %d CUs, occupancy %d per CU, grid %d\n", cus, per_cu, grid);
    }
    if (grid < 0) return;
    unsigned char* ws = (unsigned char*)d_ws;
    (void)hipMemsetAsync(ws + WS_MOD, 0, CTL_ZERO_BYTES, stream);
    Params p; memset(&p, 0, sizeof(p));
    const float* const* in = (const float* const*)d_in;
    p.x = in[0]; p.c = in[1]; p.pos = (const int*)d_in[2];
    p.w_in_ab = in[3]; p.b_forget = in[4]; p.lam_re = in[5]; p.lam_im = in[6]; p.log_dt = in[7]; p.b_re = in[8]; p.b_im = in[9]; p.c_re = in[10]; p.c_im = in[11]; p.ssm_d = in[12];
    p.w_glu = in[13]; p.b_glu = in[14]; p.w_out_ab = in[15]; p.w_in_c = in[16]; p.sinks = in[17]; p.w_out_c = in[18]; p.w_ada = in[19]; p.b_ada = in[20];
    p.ln_mix_g = in[21]; p.ln_mix_b = in[22]; p.ln_ffn_g = in[23]; p.ln_ffn_b = in[24]; p.w_gate = in[25]; p.w_up = in[26]; p.w_down = in[27];
    p.out = (float*)d_out; p.ws = ws;
    int n = 0, items = 0;
    add_td(p, n, items, p.w_in_ab, (bf16*)(ws + WS_W1T), EVEN_IN, DM, 2 * FW, 0, 0);
    add_td(p, n, items, p.w_in_ab + 3 * FW + 8, (bf16*)(ws + WS_W1T), EVEN_IN, DM, FW, 0, 2 * FW);
    add_td(p, n, items, p.w_in_ab + 2 * FW, (bf16*)(ws + WS_WVT), EVEN_IN, DM, FW, 0, 0);
    add_td(p, n, items, p.w_glu, (bf16*)(ws + WS_WGLU), FW, FW, FW, 0, 0);
    add_td(p, n, items, p.w_out_ab, (bf16*)(ws + WS_WOUT), DM, DM, DM, 0, 0);
    add_td(p, n, items, p.w_in_c, (bf16*)(ws + WS_WC1T), ODD_IN, DM, DM + KVW, 0, 0);
    add_td(p, n, items, p.w_in_c + DM + KVW, (bf16*)(ws + WS_WCVT), ODD_IN, DM, KVW, 0, 0);
    add_td(p, n, items, p.w_out_c, (bf16*)(ws + WS_WOC), DM, DM, DM, 0, 0);
    for (int l = 0; l < 2; ++l) {
        if (l == 1) p.n_items_p0 = items;
        bf16* gu = (bf16*)(ws + (l == 0 ? WS_WGU0 : WS_WGU1)); bf16* dn = (bf16*)(ws + (l == 0 ? WS_WD0 : WS_WD1));
        add_td(p, n, items, p.w_gate + (size_t)l * DM * DFF, gu, DFF, DM, DFF, 1, 0);
        add_td(p, n, items, p.w_up + (size_t)l * DM * DFF, gu, DFF, DM, DFF, 1, 128);
        add_td(p, n, items, p.w_down + (size_t)l * DFF * DM, dn, DM, DFF, DM, 0, 0);
    }
    p.n_items = items;
    void* args[] = {&p};
    hipError_t e = hipLaunchCooperativeKernel((const void*)mega_fwd, dim3(grid), dim3(NTHR), args, LDS_BYTES, stream);
    if (e != hipSuccess) fprintf(stderr, "kernel_launch: cooperative launch failed: %s (grid %d)\n", hipGetErrorString(e), grid);
}
```
